# Optimizing an MI355X kernel written in HIP

```python
import math
import jax, jax.numpy as jnp
from jax import lax
import numpy as np


D_MODEL = 1024
BATCH = 4
SEQ = 4096
DEPTH = 4
DEC_BATCH = 16
DEC_SEQ = 2048
PAST_LEN = 128

D_ATTN = 512
N_Q_HEADS = 8
N_KV_HEADS = 2
HEAD_DIM = 64
Q_PER_KV = N_Q_HEADS // N_KV_HEADS
KV_DIM = N_KV_HEADS * HEAD_DIM
WINDOW = 128
BLOCK = 128
D_LRU = 512
N_LRU_BLOCKS = 8
LRU_BLOCK = D_LRU // N_LRU_BLOCKS
CONV_WIDTH = 4
CONV_PAD_LEFT = 2
CONV_PAD_RIGHT = CONV_WIDTH - 1 - CONV_PAD_LEFT
LRU_C = 8.0
N_DIR = 2
D_MIX = D_ATTN + D_LRU
D_IN = D_ATTN + 2 * KV_DIM + 2 * D_LRU
D_FF = ((8 * D_MODEL + 2) // 3 + 255) // 256 * 256
N_MOD = 6
EPS = 1e-6

kernel_name = 'hybrid_bidir_rglru_swa_encoder'


def rmsnorm(x, g):
    xf = x.astype(jnp.float32)
    y = xf * lax.rsqrt(jnp.mean(xf * xf, axis=-1, keepdims=True) + EPS)
    return (y * g.astype(jnp.float32)).astype(x.dtype)


def alibi_slopes():
    h = jnp.arange(N_Q_HEADS, dtype=jnp.float32) + 1.0
    return jnp.exp2(-8.0 * h / N_Q_HEADS)


def banded_attention(q, k, v, sink):
    B, S = q.shape[0], q.shape[1]
    nb = S // BLOCK
    f32 = jnp.float32
    qb = q.astype(f32).reshape(B, nb, BLOCK, N_KV_HEADS, Q_PER_KV, HEAD_DIM)
    pad = ((0, 0), (BLOCK, BLOCK), (0, 0))
    kp = jnp.pad(k.astype(f32), pad).reshape(B, nb + 2, BLOCK, N_KV_HEADS, HEAD_DIM)
    vp = jnp.pad(v.astype(f32), pad).reshape(B, nb + 2, BLOCK, N_KV_HEADS, HEAD_DIM)
    kb = jnp.concatenate([kp[:, :-2], kp[:, 1:-1], kp[:, 2:]], axis=2)
    vb = jnp.concatenate([vp[:, :-2], vp[:, 1:-1], vp[:, 2:]], axis=2)
    scores = jnp.einsum('bnqkgd,bnskd->bnkgqs', qb, kb) * (HEAD_DIM ** -0.5)
    tq = jnp.arange(S).reshape(nb, BLOCK)
    ts = (jnp.arange(nb)[:, None] - 1) * BLOCK + jnp.arange(3 * BLOCK)[None, :]
    dist = jnp.abs(tq[:, :, None] - ts[:, None, :])
    valid = (dist <= WINDOW) & (ts[:, None, :] >= 0) & (ts[:, None, :] < S)
    slopes = alibi_slopes().reshape(N_KV_HEADS, Q_PER_KV)
    bias = -slopes[None, :, :, None, None] * dist[:, None, None].astype(f32)
    logits = jnp.where(valid[None, :, None, None], scores + bias[None], -1e30)
    sink_col = jnp.broadcast_to(
        sink.astype(f32).reshape(N_KV_HEADS, Q_PER_KV)[None, None, :, :, None, None],
        logits.shape[:-1] + (1,))
    p = jax.nn.softmax(jnp.concatenate([logits, sink_col], axis=-1), axis=-1)[..., :-1]
    out = jnp.einsum('bnkgqs,bnskd->bnqkgd', p, vb)
    return out.reshape(B, S, D_ATTN).astype(q.dtype)


def _lin_combine(e1, e2):
    a1, b1 = e1
    a2, b2 = e2
    return a1 * a2, a2 * b1 + b2


def rglru_bidir(x, conv_w, conv_b, w_rg, b_rg, w_ig, b_ig, lam):
    B, S = x.shape[0], x.shape[1]
    f32 = jnp.float32
    xp = jnp.pad(x, ((0, 0), (CONV_PAD_LEFT, CONV_PAD_RIGHT), (0, 0)))
    xc = conv_b
    for j in range(CONV_WIDTH):
        xc = xc + xp[:, j:j + S] * conv_w[j]
    xf = xc.astype(f32)
    xblk = xf.reshape(B, S, N_LRU_BLOCKS, LRU_BLOCK)
    r = jax.nn.sigmoid(jnp.einsum('bsnc,dncm->dbsnm', xblk, w_rg.astype(f32)).reshape(N_DIR, B, S, D_LRU)
                       + b_rg.astype(f32)[:, None, None, :])
    i = jax.nn.sigmoid(jnp.einsum('bsnc,dncm->dbsnm', xblk, w_ig.astype(f32)).reshape(N_DIR, B, S, D_LRU)
                       + b_ig.astype(f32)[:, None, None, :])
    log_a = LRU_C * r * jax.nn.log_sigmoid(lam.astype(f32))[:, None, None, :]
    a = jnp.exp(log_a)
    u = jnp.sqrt(jnp.maximum(1.0 - a * a, 0.0)) * (i * xf[None])
    _, h_fwd = lax.associative_scan(_lin_combine, (a[0], u[0]), axis=1)
    _, h_bwd = lax.associative_scan(_lin_combine, (a[1], u[1]), axis=1, reverse=True)
    return (h_fwd + h_bwd).astype(x.dtype)


def trunk(x, c, w_mod, b_mod, g_norm1, w_in, sink, conv_w, conv_b, w_rg, b_rg, w_ig, b_ig, lam,
          g_attn_out, g_lru_out, w_out, g_norm2, w_ffn_in, w_ffn_out, g_final):
    c_act = jax.nn.silu(c)
    s1 = D_ATTN
    s2 = s1 + KV_DIM
    s3 = s2 + KV_DIM
    s4 = s3 + D_LRU
    for l in range(DEPTH):
        mod = (c_act @ w_mod[l] + b_mod[l])[:, None, :]
        sh1, sc1, gt1, sh2, sc2, gt2 = jnp.split(mod, N_MOD, axis=-1)
        h = rmsnorm(x, g_norm1[l]) * (1.0 + sc1) + sh1
        z = h @ w_in[l]
        q, k, v, xr, gate = jnp.split(z, [s1, s2, s3, s4], axis=-1)
        attn = banded_attention(q, k, v, sink[l])
        lru = rglru_bidir(xr, conv_w[l], conv_b[l], w_rg[l], b_rg[l], w_ig[l], b_ig[l], lam[l])
        lru = lru * jax.nn.gelu(gate)
        mix = jnp.concatenate([rmsnorm(attn, g_attn_out[l]), rmsnorm(lru, g_lru_out[l])], axis=-1)
        x = x + gt1 * (mix @ w_out[l])
        h = rmsnorm(x, g_norm2[l]) * (1.0 + sc2) + sh2
        gu = h @ w_ffn_in[l]
        g_, u_ = jnp.split(gu, 2, axis=-1)
        x = x + gt2 * ((jax.nn.silu(g_) * u_) @ w_ffn_out[l])
    return rmsnorm(x, g_final)


def setup_inputs(seed: int = 0) -> dict:
    key = jax.random.key(seed)
    ks = jax.random.split(key, 32)
    f32 = jnp.float32
    nrm = lambda k, shape, s: jax.random.normal(k, shape, f32) * s
    u = jax.random.uniform(ks[14], (DEPTH, N_DIR, D_LRU), f32, 0.9, 0.999)
    p = u ** (1.0 / LRU_C)
    lam = jnp.log(p) - jnp.log1p(-p)
    return {
        'x_prompt': nrm(ks[0], (BATCH, SEQ, D_MODEL), 1.0),
        'x_sample': nrm(ks[1], (DEC_BATCH, DEC_SEQ, D_MODEL), 1.0),
        'c_prompt': nrm(ks[2], (BATCH, D_MODEL), 1.0),
        'c_sample': nrm(ks[3], (DEC_BATCH, D_MODEL), 1.0),
        'w_mod': nrm(ks[4], (DEPTH, D_MODEL, N_MOD * D_MODEL), 0.5 * D_MODEL ** -0.5),
        'b_mod': nrm(ks[5], (DEPTH, N_MOD * D_MODEL), 0.02),
        'g_norm1': 1.0 + nrm(ks[6], (DEPTH, D_MODEL), 0.02),
        'w_in': nrm(ks[7], (DEPTH, D_MODEL, D_IN), D_MODEL ** -0.5),
        'sink': nrm(ks[8], (DEPTH, N_Q_HEADS), 0.5),
        'conv_w': nrm(ks[9], (DEPTH, CONV_WIDTH, D_LRU), CONV_WIDTH ** -0.5),
        'conv_b': nrm(ks[10], (DEPTH, D_LRU), 0.02),
        'w_rg': nrm(ks[11], (DEPTH, N_DIR, N_LRU_BLOCKS, LRU_BLOCK, LRU_BLOCK), LRU_BLOCK ** -0.5),
        'b_rg': nrm(ks[12], (DEPTH, N_DIR, D_LRU), 0.02),
        'w_ig': nrm(ks[13], (DEPTH, N_DIR, N_LRU_BLOCKS, LRU_BLOCK, LRU_BLOCK), LRU_BLOCK ** -0.5),
        'b_ig': nrm(ks[15], (DEPTH, N_DIR, D_LRU), 0.02),
        'lam': lam,
        'g_attn_out': 1.0 + nrm(ks[16], (DEPTH, D_ATTN), 0.02),
        'g_lru_out': 1.0 + nrm(ks[17], (DEPTH, D_LRU), 0.02),
        'w_out': nrm(ks[18], (DEPTH, D_MIX, D_MODEL), D_MIX ** -0.5),
        'g_norm2': 1.0 + nrm(ks[19], (DEPTH, D_MODEL), 0.02),
        'w_ffn_in': nrm(ks[20], (DEPTH, D_MODEL, 2 * D_FF), D_MODEL ** -0.5),
        'w_ffn_out': nrm(ks[21], (DEPTH, D_FF, D_MODEL), D_FF ** -0.5),
        'g_final': 1.0 + nrm(ks[22], (D_MODEL,), 0.02),
    }


def reference(x_prompt, x_sample, c_prompt, c_sample, w_mod, b_mod, g_norm1, w_in, sink, conv_w, conv_b,
              w_rg, b_rg, w_ig, b_ig, lam, g_attn_out, g_lru_out, w_out, g_norm2, w_ffn_in, w_ffn_out, g_final):
    y_prompt = trunk(x_prompt, c_prompt, w_mod, b_mod, g_norm1, w_in, sink, conv_w, conv_b, w_rg, b_rg,
                     w_ig, b_ig, lam, g_attn_out, g_lru_out, w_out, g_norm2, w_ffn_in, w_ffn_out, g_final)
    y_sample = trunk(x_sample, c_sample, w_mod, b_mod, g_norm1, w_in, sink, conv_w, conv_b, w_rg, b_rg,
                     w_ig, b_ig, lam, g_attn_out, g_lru_out, w_out, g_norm2, w_ffn_in, w_ffn_out, g_final)
    return (y_prompt, y_sample)
```

```cpp
#include <hip/hip_runtime.h>
#include <hip/hip_cooperative_groups.h>
#include <cstdio>
#include <cstdint>
namespace cg = cooperative_groups;

constexpr int MTOK = 49152, DM = 1024, DIN = 1792, DFF = 2816, NFI = 5632, NLAYER = 4, NB = 20, NMODC = 6144;
constexpr float EPS = 1e-6f, LOG2E = 1.4426950408889634f;
__device__ __forceinline__ int row_batch(int row) { return row < 16384 ? (row >> 12) : 4 + ((row - 16384) >> 11); }
__device__ __forceinline__ int batch_row0(int b) { return b < 4 ? b * 4096 : 16384 + (b - 4) * 2048; }
__device__ __forceinline__ int batch_len(int b) { return b < 4 ? 4096 : 2048; }
namespace pg8 {
#define PG8_LAS __attribute__((address_space(3)))
typedef unsigned short bf16_t;
typedef short bf16x8 __attribute__((ext_vector_type(8)));
typedef float f32x4 __attribute__((ext_vector_type(4)));
typedef unsigned u32x4 __attribute__((ext_vector_type(4)));
constexpr int BM = 256, BK = 64, HALF = 128, HTB = HALF * BK * 2  , STAGE_BYTES = 8 * HTB, NXCD = 8, WGM = 8;

__host__ __device__ __forceinline__ int lds_byte(int r, int c) { const int st = (r >> 4) * 2 + (c >> 5), rr = r & 15, cc = c & 31, ob = rr * 64 + cc * 2; return st * 1024 + (ob ^ (((ob >> 9) & 1) << 5)); }
__host__ __device__ __forceinline__ void stage_rc(int b, int& R, int& C) { const int st = b / 1024, sb = b % 1024, swz = sb ^ (((sb >> 9) & 1) << 5); R = (st >> 1) * 16 + swz / 64; C = (st & 1) * 32 + (swz % 64) / 2; }
__host__ __device__ __forceinline__ int perm32(int rho) { const int n = rho >> 4, i = rho & 15; return 8 * (i >> 2) + 4 * n + (i & 3); }

struct Unit { int pm, pn; };
struct Gemm { const bf16_t* A; const bf16_t* Bt; int M, N, K; };

struct StaticOrder {
    int nM, nN, nwg, G, c;
    __host__ __device__ void init(int M, int N, int G_, int c_) { nM = M / BM; nN = N / BM; nwg = nM * nN; G = G_; c = c_; }
    __host__ __device__ bool next(int i, Unit& u) const {
        const long L = (long)i * G + c; if (L >= nwg) return false;
        int wgid = (int)L; { const int q = nwg / NXCD, r = nwg % NXCD, xcd = wgid % NXCD, off = wgid / NXCD; wgid = (xcd < r ? xcd * (q + 1) : r * (q + 1) + (xcd - r) * q) + off; }
        const int nig = WGM * nN, gid = wgid / nig, fm = gid * WGM, gsz = (nM - fm) < WGM ? (nM - fm) : WGM;
        u.pm = fm + ((wgid % nig) % gsz); u.pn = (wgid % nig) / gsz; return true;
    }
    __device__ __forceinline__ void a_ready(const Unit&) const {}
    __device__ __forceinline__ void done(const Unit&) const {}
};

__device__ __forceinline__ unsigned cvt_pk_bf16(float lo, float hi) { unsigned r; asm("v_cvt_pk_bf16_f32 %0, %1, %2" : "=v"(r) : "v"(lo), "v"(hi)); return r; }
__device__ __forceinline__ float row_rstd(const float* rowsq, int row) {
    float s = 0.f;
#pragma unroll
    for (int p = 0; p < 16; ++p) s += rowsq[(size_t)p * MTOK + row];
    return rsqrtf(s * (1.0f / DM) + EPS);
}
struct EpiZ {
    static constexpr bool PERM = true, AFTER_DRAIN = false;
    bf16_t* O; int ldc; const float* rowsq; const float* shw;
    __device__ __forceinline__ void operator()(const f32x4 (&acc)[2][2][4][2], const Unit& u, int wr, int wc, int fr, int fq) const {
        const int row0 = u.pm * BM + wr * 64 + fr; const int b = row_batch(u.pm * BM);
        const int col0 = u.pn * BM + wc * 32 + 8 * fq;
        f32x4 bv[2][2];
#pragma unroll
        for (int bj = 0; bj < 2; ++bj)
#pragma unroll
            for (int n = 0; n < 2; ++n) bv[bj][n] = *(const f32x4*)(shw + (size_t)b * ldc + col0 + bj * HALF + 4 * n);
#pragma unroll
        for (int ai = 0; ai < 2; ++ai)
#pragma unroll
            for (int m = 0; m < 4; ++m) { const int row = row0 + ai * HALF + m * 16; const float rs = row_rstd(rowsq, row);
                bf16_t* rowp = O + (size_t)row * ldc + col0;
#pragma unroll
                for (int bj = 0; bj < 2; ++bj) { const f32x4 v0 = acc[ai][bj][m][0] * rs + bv[bj][0], v1 = acc[ai][bj][m][1] * rs + bv[bj][1];
                    u32x4 w; w.x = cvt_pk_bf16(v0[0], v0[1]); w.y = cvt_pk_bf16(v0[2], v0[3]); w.z = cvt_pk_bf16(v1[0], v1[1]); w.w = cvt_pk_bf16(v1[2], v1[3]);
                    *(u32x4*)(rowp + bj * HALF) = w; } }
    }
};
struct EpiSwiGLU {
    static constexpr bool PERM = true, AFTER_DRAIN = false;
    bf16_t* O; const float* rowsq; const float* shw;
    __device__ __forceinline__ void operator()(const f32x4 (&acc)[2][2][4][2], const Unit& u, int wr, int wc, int fr, int fq) const {
        const int row0 = u.pm * BM + wr * 64 + fr; const int b = row_batch(u.pm * BM);
        const int col0 = u.pn * BM + wc * 32 + 8 * fq, ocol = u.pn * HALF + wc * 32 + 8 * fq;
        f32x4 bv[2][2];
#pragma unroll
        for (int bj = 0; bj < 2; ++bj)
#pragma unroll
            for (int n = 0; n < 2; ++n) bv[bj][n] = *(const f32x4*)(shw + (size_t)b * NFI + col0 + bj * HALF + 4 * n);
#pragma unroll
        for (int ai = 0; ai < 2; ++ai)
#pragma unroll
            for (int m = 0; m < 4; ++m) { const int row = row0 + ai * HALF + m * 16; const float rs = row_rstd(rowsq, row);
                float o[8];
#pragma unroll
                for (int n = 0; n < 2; ++n) { const f32x4 g = acc[ai][0][m][n] * rs + bv[0][n], uu = acc[ai][1][m][n] * rs + bv[1][n];
#pragma unroll
                    for (int j = 0; j < 4; ++j) { const float s = __builtin_amdgcn_rcpf(1.0f + __builtin_amdgcn_exp2f(-LOG2E * g[j])); o[4 * n + j] = g[j] * s * uu[j]; } }
                u32x4 w; w.x = cvt_pk_bf16(o[0], o[1]); w.y = cvt_pk_bf16(o[2], o[3]); w.z = cvt_pk_bf16(o[4], o[5]); w.w = cvt_pk_bf16(o[6], o[7]);
                *(u32x4*)(O + (size_t)row * DFF + ocol) = w; }
    }
};
struct EpiRes {
    static constexpr bool PERM = true, AFTER_DRAIN = false;
    float* x; const float* gt; const float* gn; const float* sc; bf16_t* hb; float* rowsq_out;
    __device__ __forceinline__ void operator()(const f32x4 (&acc)[2][2][4][2], const Unit& u, int wr, int wc, int fr, int fq) const {
        const int row0 = u.pm * BM + wr * 64 + fr; const int b = row_batch(u.pm * BM);
        const int col0 = u.pn * BM + wc * 32 + 8 * fq;
        f32x4 gv[2][2], mv[2][2];
#pragma unroll
        for (int bj = 0; bj < 2; ++bj)
#pragma unroll
            for (int n = 0; n < 2; ++n) { const int c = col0 + bj * HALF + 4 * n; gv[bj][n] = *(const f32x4*)(gt + (size_t)b * NMODC + c);
                if (hb) { const f32x4 g4 = *(const f32x4*)(gn + c), s4 = *(const f32x4*)(sc + (size_t)b * NMODC + c); mv[bj][n] = g4 * (s4 + 1.0f); } else mv[bj][n] = (f32x4){0.f, 0.f, 0.f, 0.f}; }
#pragma unroll
        for (int ai = 0; ai < 2; ++ai)
#pragma unroll
            for (int m = 0; m < 4; ++m) { const int row = row0 + ai * HALF + m * 16; float* xp = x + (size_t)row * DM + col0; float ss = 0.f;
#pragma unroll
                for (int bj = 0; bj < 2; ++bj) { f32x4 xn[2];
#pragma unroll
                    for (int n = 0; n < 2; ++n) { const f32x4 xv = *(const f32x4*)(xp + bj * HALF + 4 * n); xn[n] = xv + gv[bj][n] * acc[ai][bj][m][n];
                        *(f32x4*)(xp + bj * HALF + 4 * n) = xn[n]; ss += (xn[n][0] * xn[n][0] + xn[n][1] * xn[n][1]) + (xn[n][2] * xn[n][2] + xn[n][3] * xn[n][3]); }
                    if (hb) { const f32x4 h0 = xn[0] * mv[bj][0], h1 = xn[1] * mv[bj][1];
                        u32x4 w; w.x = cvt_pk_bf16(h0[0], h0[1]); w.y = cvt_pk_bf16(h0[2], h0[3]); w.z = cvt_pk_bf16(h1[0], h1[1]); w.w = cvt_pk_bf16(h1[2], h1[3]);
                        *(u32x4*)(hb + (size_t)row * DM + col0 + bj * HALF) = w; } }
                ss += __shfl_xor(ss, 16); ss += __shfl_xor(ss, 32);
                if (fq == 0) rowsq_out[(size_t)(u.pn * 4 + wc) * MTOK + row] = ss; }
    }
};

template <class Epi, class Sched, bool ALIGN_EPI = false, bool SP2 = false>
__device__ __forceinline__ void gemm_phase(PG8_LAS unsigned char* lds, const Gemm g, const Sched& S, const Epi& E) {
    int tid_ = threadIdx.x; asm volatile("" : "+v"(tid_)); const int tid = tid_, wid = __builtin_amdgcn_readfirstlane(tid >> 6), lane = tid & 63, wr = wid >> 2, wc = wid & 3, fr = lane & 15, fq = lane >> 4;
    const int K = g.K, nt = K / BK;
    unsigned voffA[2], voffB[2];
#pragma unroll
    for (int i = 0; i < 2; ++i) { int R, C; stage_rc(tid * 16 + i * 8192, R, C); const int Rb = Epi::PERM ? ((R & ~31) + perm32(R & 31)) : R;
        voffA[i] = (unsigned)(R * K + C) * 2u; voffB[i] = (unsigned)(Rb * K + C) * 2u; }
    const size_t kstep = (size_t)(BK * 2);
    const size_t hstep = (size_t)HALF * K * 2;
    const size_t tstep = 2 * hstep;
    const unsigned ldsw = (unsigned)wid * 1024u;
    const int aoff = lds_byte(wr * 64 + fr, fq * 8), boff = lds_byte(wc * 32 + fr, fq * 8);
#define PG8_SA(b, h) (((b) * 2 + (h)) * HTB)
#define PG8_SB(b, h) ((4 + (b) * 2 + (h)) * HTB)
#define PG8_STAGE(bufoff, gbase, voff) do { _Pragma("unroll") for (int _i = 0; _i < 2; ++_i) \
        __builtin_amdgcn_global_load_lds((const unsigned*)((const char*)(gbase) + (voff)[_i]), (PG8_LAS unsigned*)(lds + (bufoff) + ldsw + _i * 8192), 16, 0, 0); } while (0)
#define PG8_LDA(dst, b, h) do { _Pragma("unroll") for (int m = 0; m < 4; ++m) _Pragma("unroll") for (int k = 0; k < 2; ++k) dst[m][k] = *(const PG8_LAS bf16x8*)(lds + PG8_SA(b, h) + aoff + m * 2048 + k * 1024); } while (0)
#define PG8_LDB(dst, b, h) do { _Pragma("unroll") for (int n = 0; n < 2; ++n) _Pragma("unroll") for (int k = 0; k < 2; ++k) dst[n][k] = *(const PG8_LAS bf16x8*)(lds + PG8_SB(b, h) + boff + n * 2048 + k * 1024); } while (0)
#define PG8_MMA(ai, bj, At, Bt) do { __builtin_amdgcn_s_setprio(1); _Pragma("unroll") for (int m = 0; m < 4; ++m) _Pragma("unroll") for (int n = 0; n < 2; ++n) _Pragma("unroll") for (int k = 0; k < 2; ++k) \
        acc[ai][bj][m][n] = __builtin_amdgcn_mfma_f32_16x16x32_bf16(Bt[n][k], At[m][k], acc[ai][bj][m][n], 0, 0, 0); __builtin_amdgcn_s_setprio(0); } while (0)
#define PG8_WAIT_V(n) asm volatile("s_waitcnt vmcnt(" #n ")" ::: "memory")
#define PG8_WAIT_L(n) asm volatile("s_waitcnt lgkmcnt(" #n ")" ::: "memory")
#define PG8_BAR __builtin_amdgcn_s_barrier()
#define PG8_SCHED __builtin_amdgcn_sched_barrier(0)
    Unit cur, nxt; int ui = 0;
    if (!S.next(0, cur)) return;
    f32x4 acc[2][2][4][2];
#pragma unroll
    for (int a = 0; a < 2; ++a)
#pragma unroll
        for (int b = 0; b < 2; ++b)
#pragma unroll
            for (int m = 0; m < 4; ++m)
#pragma unroll
                for (int n = 0; n < 2; ++n) acc[a][b][m][n] = (f32x4){0.f, 0.f, 0.f, 0.f};
    bf16x8 At[4][2], B0[2][2], B1[2][2];
    const char* cA = (const char*)g.A + (size_t)cur.pm * tstep; const char* cB = (const char*)g.Bt + (size_t)cur.pn * tstep;
    S.a_ready(cur);
    if constexpr (SP2) {
        PG8_STAGE(PG8_SB(0, 0), cB, voffB); PG8_STAGE(PG8_SB(0, 1), cB + hstep, voffB); PG8_STAGE(PG8_SA(0, 0), cA, voffA); PG8_STAGE(PG8_SA(0, 1), cA + hstep, voffA);
        if (wr == 1) PG8_BAR;
        PG8_WAIT_V(2); PG8_BAR;
        PG8_STAGE(PG8_SB(1, 0), cB + kstep, voffB); PG8_STAGE(PG8_SA(1, 0), cA + kstep, voffA); PG8_STAGE(PG8_SB(1, 1), cB + hstep + kstep, voffB);
        PG8_WAIT_V(6); PG8_BAR;
    } else {
        PG8_STAGE(PG8_SB(0, 0), cB, voffB); PG8_STAGE(PG8_SA(0, 0), cA, voffA); PG8_STAGE(PG8_SB(0, 1), cB + hstep, voffB); PG8_STAGE(PG8_SA(0, 1), cA + hstep, voffA);
        if (wr == 1) PG8_BAR;
        PG8_WAIT_V(4); PG8_BAR;
        PG8_STAGE(PG8_SB(1, 0), cB + kstep, voffB); PG8_STAGE(PG8_SA(1, 0), cA + kstep, voffA); PG8_STAGE(PG8_SB(1, 1), cB + hstep + kstep, voffB);
        PG8_WAIT_V(6); PG8_BAR;
    }
    for (;;) {
        const bool has_next = S.next(ui + 1, nxt);
        const char* nA = has_next ? (const char*)g.A + (size_t)nxt.pm * tstep : cA; const char* nB = has_next ? (const char*)g.Bt + (size_t)nxt.pn * tstep : cB;
        for (int t = 0; t < nt; t += 2) {
            const bool last = (t == nt - 2);
            const char* a1 = cA + (size_t)(t + 1) * kstep;
            const char* a2 = last ? nA : cA + (size_t)(t + 2) * kstep; const char* b2 = last ? nB : cB + (size_t)(t + 2) * kstep;
            const char* a3 = a2 + kstep; const char* b3 = b2 + kstep;
            if (last && has_next) S.a_ready(nxt);
            if constexpr (SP2) {
            PG8_LDB(B0, 0, 0); PG8_LDB(B1, 0, 1); PG8_SCHED; PG8_LDA(At, 0, 0); PG8_STAGE(PG8_SA(1, 1), a1 + hstep, voffA);
            PG8_WAIT_V(8); PG8_WAIT_L(0); PG8_BAR; PG8_MMA(0, 0, At, B0); PG8_MMA(0, 1, At, B1); PG8_BAR; PG8_SCHED;
            PG8_LDA(At, 0, 1); PG8_STAGE(PG8_SB(0, 0), b2, voffB); PG8_STAGE(PG8_SB(0, 1), b2 + hstep, voffB); PG8_STAGE(PG8_SA(0, 0), a2, voffA);
            PG8_WAIT_V(8); PG8_WAIT_L(0); PG8_BAR; PG8_MMA(1, 0, At, B0); PG8_MMA(1, 1, At, B1); PG8_BAR; PG8_SCHED;
            PG8_LDB(B0, 1, 0); PG8_LDB(B1, 1, 1); PG8_SCHED; PG8_LDA(At, 1, 0); PG8_STAGE(PG8_SA(0, 1), a2 + hstep, voffA);
            PG8_WAIT_V(8); PG8_WAIT_L(0); PG8_BAR; PG8_MMA(0, 0, At, B0); PG8_MMA(0, 1, At, B1); PG8_BAR; PG8_SCHED;
            PG8_LDA(At, 1, 1); PG8_STAGE(PG8_SB(1, 0), b3, voffB); PG8_STAGE(PG8_SB(1, 1), b3 + hstep, voffB); PG8_STAGE(PG8_SA(1, 0), a3, voffA);
            PG8_WAIT_V(8); PG8_WAIT_L(0); PG8_BAR; PG8_MMA(1, 0, At, B0); PG8_MMA(1, 1, At, B1); PG8_BAR; PG8_SCHED;
            } else {
            PG8_LDB(B0, 0, 0); PG8_SCHED; PG8_LDA(At, 0, 0); PG8_STAGE(PG8_SA(1, 1), a1 + hstep, voffA);
            PG8_WAIT_L(8); PG8_BAR; PG8_WAIT_L(0); PG8_MMA(0, 0, At, B0); PG8_BAR; PG8_SCHED;
            PG8_LDB(B1, 0, 1); PG8_STAGE(PG8_SB(0, 0), b2, voffB);
            PG8_BAR; PG8_WAIT_L(0); PG8_MMA(0, 1, At, B1); PG8_BAR;
            PG8_LDA(At, 0, 1); PG8_STAGE(PG8_SA(0, 0), a2, voffA);
            PG8_BAR; PG8_WAIT_L(0); PG8_MMA(1, 0, At, B0); PG8_BAR; PG8_SCHED;
            PG8_STAGE(PG8_SB(0, 1), b2 + hstep, voffB);
            PG8_WAIT_V(6); PG8_BAR; PG8_MMA(1, 1, At, B1); PG8_BAR;
            PG8_LDB(B0, 1, 0); PG8_SCHED; PG8_LDA(At, 1, 0); PG8_STAGE(PG8_SA(0, 1), a2 + hstep, voffA);
            PG8_WAIT_L(8); PG8_BAR; PG8_WAIT_L(0); PG8_MMA(0, 0, At, B0); PG8_BAR; PG8_SCHED;
            PG8_LDB(B1, 1, 1); PG8_STAGE(PG8_SB(1, 0), b3, voffB);
            PG8_BAR; PG8_WAIT_L(0); PG8_MMA(0, 1, At, B1); PG8_BAR;
            PG8_LDA(At, 1, 1); PG8_STAGE(PG8_SA(1, 0), a3, voffA);
            PG8_BAR; PG8_WAIT_L(0); PG8_MMA(1, 0, At, B0); PG8_BAR; PG8_SCHED;
            PG8_STAGE(PG8_SB(1, 1), b3 + hstep, voffB);
            PG8_WAIT_V(6); PG8_BAR; PG8_MMA(1, 1, At, B1); PG8_BAR;
            }
        }
        if constexpr (ALIGN_EPI) { if (wr == 0) PG8_BAR; }
        if constexpr (!Epi::AFTER_DRAIN) { E(acc, cur, wr, wc, fr, fq); S.done(cur); }
        if (!has_next) break;
#pragma unroll
        for (int a = 0; a < 2; ++a)
#pragma unroll
            for (int b = 0; b < 2; ++b)
#pragma unroll
                for (int m = 0; m < 4; ++m)
#pragma unroll
                    for (int n = 0; n < 2; ++n) acc[a][b][m][n] = (f32x4){0.f, 0.f, 0.f, 0.f};
        cur = nxt; cA = nA; cB = nB; ++ui;
        if constexpr (ALIGN_EPI) { if (wr == 1) PG8_BAR; }
    }
    PG8_WAIT_V(0);
    if constexpr (!ALIGN_EPI) { if (wr == 0) PG8_BAR; }
    PG8_BAR;
    if constexpr (Epi::AFTER_DRAIN) { E.fused(acc, cur, wr, wc, fr, fq, lds, wid, lane); S.done(cur); }
#undef PG8_SA
#undef PG8_SB
#undef PG8_STAGE
#undef PG8_LDA
#undef PG8_LDB
#undef PG8_MMA
#undef PG8_WAIT_V
#undef PG8_WAIT_L
#undef PG8_BAR
#undef PG8_SCHED
}
}

#define LAS __attribute__((address_space(3)))
typedef unsigned short bf16_t;
typedef short bf16x8 __attribute__((ext_vector_type(8)));
typedef float f32x4 __attribute__((ext_vector_type(4)));
typedef float f32x2 __attribute__((ext_vector_type(2)));
typedef float f32x16 __attribute__((ext_vector_type(16)));
typedef unsigned u32x4 __attribute__((ext_vector_type(4)));
typedef unsigned u32x2 __attribute__((ext_vector_type(2)));
#define LDS_WAIT() asm volatile("s_waitcnt lgkmcnt(0)" ::: "memory")
__device__ __forceinline__ int opaque_tid() { int t = threadIdx.x; asm volatile("" : "+v"(t)); return t; }
using pg8::cvt_pk_bf16;
__device__ __forceinline__ float bf2f(unsigned v16) { return __uint_as_float(v16 << 16); }
__device__ __forceinline__ float fexp2(float x) { return __builtin_amdgcn_exp2f(x); }
__device__ __forceinline__ float frcp(float x) { return __builtin_amdgcn_rcpf(x); }
__device__ __forceinline__ float fsigmoid(float x) { return frcp(1.0f + fexp2(-LOG2E * x)); }
__device__ __forceinline__ float wave_sum(float v) {
#pragma unroll
    for (int o = 1; o < 64; o <<= 1) v += __shfl_xor(v, o);
    return v;
}

constexpr size_t MiB = 1u << 20;
constexpr size_t WS_WIN = 1 * MiB, WS_WOUT = 15 * MiB, WS_WFI = 23 * MiB, WS_WFO = 67 * MiB, WS_WG = 89 * MiB, WS_MOD = 90 * MiB, WS_SHW1 = 92 * MiB, WS_SHW2 = 93 * MiB,
                 WS_RSQ1 = 95 * MiB, WS_RSQ2 = 98 * MiB, WS_AGG = 101 * MiB, WS_HB = 108 * MiB, WS_Z = 204 * MiB, WS_MIX = 372 * MiB, WS_HID = 204 * MiB, WS_END = 468 * MiB;
constexpr int LDS_BYTES = 147456;

struct Args { const float* in[23]; float* out; unsigned char* ws; int pad0, pad1; };

template <int MODE> __device__ __forceinline__ void transpose_item(const float* W, int K, int N, bf16_t* WT, LAS float* scr, int item, int lane) {
    const int nblk = N / 32, kb = item / nblk, nb = item % nblk, k0 = 64 * kb, n0 = 32 * nb;
#pragma unroll 8
    for (int i = 0; i < 32; ++i) { const int kk = 2 * i + (lane >> 5); scr[kk * 33 + (lane & 31)] = W[(size_t)(k0 + kk) * N + n0 + (lane & 31)]; }
    LDS_WAIT();
    int drow0 = n0;
    if (MODE == 1) { const int half = n0 >= DFF ? 1 : 0; const int j = n0 - half * DFF; drow0 = (j >> 7) * 256 + half * 128 + (j & 127); }
    const int c = lane & 7;
#pragma unroll
    for (int j = 0; j < 4; ++j) { const int n = (lane >> 3) + 8 * j; const LAS float* s = scr + (8 * c) * 33 + n;
        u32x4 o; o.x = cvt_pk_bf16(s[0 * 33], s[1 * 33]); o.y = cvt_pk_bf16(s[2 * 33], s[3 * 33]); o.z = cvt_pk_bf16(s[4 * 33], s[5 * 33]); o.w = cvt_pk_bf16(s[6 * 33], s[7 * 33]);
        *(u32x4*)(WT + (size_t)(drow0 + n) * K + k0 + 8 * c) = o; }
    LDS_WAIT();
}

__device__ __forceinline__ void gemv20_item(const float* W, int ldw, int srccol0, LAS const float* vl, LAS float* red, float* out, int ostride, int dstcol0, const float* bias) {
    const int tid = opaque_tid(), cl = tid & 63, kg = tid >> 6;
    float acc[NB];
#pragma unroll
    for (int b = 0; b < NB; ++b) acc[b] = 0.f;
    const float* wp = W + (size_t)(kg * 128) * ldw + srccol0 + cl;
    LAS const f32x4* vp = (LAS const f32x4*)(vl + kg * 128 * NB);
#pragma unroll 4
    for (int k = 0; k < 128; ++k) { const float w = wp[(size_t)k * ldw];
#pragma unroll
        for (int q = 0; q < 5; ++q) { const f32x4 v = vp[k * 5 + q]; acc[4 * q] += v[0] * w; acc[4 * q + 1] += v[1] * w; acc[4 * q + 2] += v[2] * w; acc[4 * q + 3] += v[3] * w; } }
#pragma unroll
    for (int b = 0; b < NB; ++b) red[(kg * NB + b) * 64 + cl] = acc[b];
    __syncthreads();
    for (int o = tid; o < NB * 64; o += 512) { const int b = o >> 6, c = o & 63; float s = 0.f;
#pragma unroll
        for (int g = 0; g < 8; ++g) s += red[(g * NB + b) * 64 + c];
        if (bias) s += bias[dstcol0 + c];
        out[(size_t)b * ostride + dstcol0 + c] = s; }
    __syncthreads();
}

constexpr int YPITCH = 1040;
__device__ __forceinline__ void rms_store(LAS const unsigned char* Yl, const float* g, bf16_t* dst) {
    const int tid = opaque_tid(), tok = tid >> 3, sub = tid & 7;
    u32x4 v[8]; float ss = 0.f;
#pragma unroll
    for (int j = 0; j < 8; ++j) { v[j] = *(LAS const u32x4*)(Yl + tok * YPITCH + (j * 8 + sub) * 16);
#pragma unroll
        for (int e = 0; e < 4; ++e) { const float a = bf2f(v[j][e] & 0xffffu), b = __uint_as_float(v[j][e] & 0xffff0000u); ss += a * a + b * b; } }
    ss += __shfl_xor(ss, 1); ss += __shfl_xor(ss, 2); ss += __shfl_xor(ss, 4);
    const float rs = rsqrtf(ss * (1.0f / 512.0f) + EPS);
#pragma unroll
    for (int j = 0; j < 8; ++j) { const int c = (j * 8 + sub) * 8; const f32x4 g0 = *(const f32x4*)(g + c), g1 = *(const f32x4*)(g + c + 4);
        u32x4 o;
        o.x = cvt_pk_bf16(bf2f(v[j][0] & 0xffffu) * rs * g0[0], __uint_as_float(v[j][0] & 0xffff0000u) * rs * g0[1]);
        o.y = cvt_pk_bf16(bf2f(v[j][1] & 0xffffu) * rs * g0[2], __uint_as_float(v[j][1] & 0xffff0000u) * rs * g0[3]);
        o.z = cvt_pk_bf16(bf2f(v[j][2] & 0xffffu) * rs * g1[0], __uint_as_float(v[j][2] & 0xffff0000u) * rs * g1[1]);
        o.w = cvt_pk_bf16(bf2f(v[j][3] & 0xffffu) * rs * g1[2], __uint_as_float(v[j][3] & 0xffff0000u) * rs * g1[3]);
        *(u32x4*)(dst + (size_t)tok * DM + c) = o; }
}

__device__ __forceinline__ int crow(int r, int hi) { return (r & 3) + 8 * (r >> 2) + 4 * hi; }
__device__ __forceinline__ bf16x8 pack8(float a0, float a1, float a2, float a3, float a4, float a5, float a6, float a7) {
    u32x4 w; w.x = cvt_pk_bf16(a0, a1); w.y = cvt_pk_bf16(a2, a3); w.z = cvt_pk_bf16(a4, a5); w.w = cvt_pk_bf16(a6, a7); return __builtin_bit_cast(bf16x8, w);
}

constexpr int KPITCH = 144;
__device__ __forceinline__ void attn_unit(int cgi, const bf16_t* __restrict__ z, bf16_t* mix, const float* sink_l, const float* g_l, LAS unsigned char* lds) {
    const int tid = opaque_tid(), lane = tid & 63, r32 = lane & 31, hi = lane >> 5, h = __builtin_amdgcn_readfirstlane(tid >> 6), kv = h >> 2;
    const int row0 = cgi * 64, b = row_batch(row0), S = batch_len(b), seq0 = batch_row0(b), t0 = row0 - seq0, qb = t0 >> 6, nkb = S >> 6;
    const int kb_lo = qb - 2 < 0 ? 0 : qb - 2, kb_hi = qb + 2 > nkb - 1 ? nkb - 1 : qb + 2;
    LAS unsigned char* Kl = lds; LAS unsigned char* Vl = lds + 18432; LAS unsigned char* Yl = lds + 36864;
#pragma unroll
    for (int qt = 0; qt < 2; ++qt)
#pragma unroll
        for (int d0 = 0; d0 < 4; ++d0) { const u32x4 qv = *(const u32x4*)(z + (size_t)(row0 + 32 * qt + r32) * DIN + h * 64 + d0 * 16 + hi * 8);
            *(LAS u32x4*)(Yl + (32 * qt + r32) * YPITCH + (h * 64 + d0 * 16 + hi * 8) * 2) = qv; }
    LDS_WAIT();
    const float slope2 = fexp2(-(float)(h + 1)) * LOG2E, sc2 = 0.125f * LOG2E;
    float mrun[2], lrun[2]; f32x16 o[2][2];
#pragma unroll
    for (int qt = 0; qt < 2; ++qt) { mrun[qt] = sink_l[h] * LOG2E; lrun[qt] = hi ? 0.f : 1.f;
#pragma unroll
        for (int dh = 0; dh < 2; ++dh)
#pragma unroll
            for (int r = 0; r < 16; ++r) o[qt][dh][r] = 0.f; }
    const int s_key = tid >> 3, s_dch = tid & 7, v_kv = tid >> 8, v_dch = (tid >> 5) & 7, v_pair = tid & 31;
    u32x4 kreg[2], vreg[2];
#define ATT_LOAD(kb) do { const int krow = seq0 + (kb) * 64; \
        _Pragma("unroll") for (int i = 0; i < 2; ++i) { kreg[i] = *(const u32x4*)(z + (size_t)(krow + s_key) * DIN + 512 + i * 64 + s_dch * 8); \
            vreg[i] = *(const u32x4*)(z + (size_t)(krow + 2 * v_pair + i) * DIN + 640 + v_kv * 64 + v_dch * 8); } } while (0)
    ATT_LOAD(kb_lo);
    for (int kb = kb_lo; kb <= kb_hi; ++kb) {
        __syncthreads();
#pragma unroll
        for (int i = 0; i < 2; ++i) *(LAS u32x4*)(Kl + (i * 64 + s_key) * KPITCH + s_dch * 16) = kreg[i];
#pragma unroll
        for (int e = 0; e < 8; ++e) { const unsigned w0 = vreg[0][e >> 1], w1 = vreg[1][e >> 1];
            const unsigned lo = (e & 1) ? (w0 >> 16) : (w0 & 0xffffu), hh = (e & 1) ? (w1 & 0xffff0000u) : (w1 << 16);
            *(LAS unsigned*)(Vl + (v_kv * 64 + v_dch * 8 + e) * KPITCH + v_pair * 4) = lo | hh; }
        __syncthreads();
        if (kb < kb_hi) ATT_LOAD(kb + 1);
#pragma unroll
        for (int qt = 0; qt < 2; ++qt) {
            __builtin_amdgcn_sched_barrier(0);
            f32x16 p0, p1;
#pragma unroll
            for (int r = 0; r < 16; ++r) { p0[r] = 0.f; p1[r] = 0.f; }
#pragma unroll
            for (int d0 = 0; d0 < 4; ++d0) {
                const bf16x8 k0f = *(LAS const bf16x8*)(Kl + (kv * 64 + r32) * KPITCH + (16 * d0 + 8 * hi) * 2);
                const bf16x8 k1f = *(LAS const bf16x8*)(Kl + (kv * 64 + 32 + r32) * KPITCH + (16 * d0 + 8 * hi) * 2);
                const bf16x8 qf = *(LAS const bf16x8*)(Yl + (32 * qt + r32) * YPITCH + (h * 64 + d0 * 16 + hi * 8) * 2);
                p0 = __builtin_amdgcn_mfma_f32_32x32x16_bf16(k0f, qf, p0, 0, 0, 0);
                p1 = __builtin_amdgcn_mfma_f32_32x32x16_bf16(k1f, qf, p1, 0, 0, 0);
            }
            int dbase = t0 + 32 * qt + r32 - kb * 64 - 4 * hi; asm volatile("" : "+v"(dbase));
            float bm = -1e30f;
#pragma unroll
            for (int r = 0; r < 16; ++r) { const int dd = dbase - ((r & 3) + 8 * (r >> 2));
                int d_0 = dd; d_0 = d_0 < 0 ? -d_0 : d_0; int d_1 = dd - 32; d_1 = d_1 < 0 ? -d_1 : d_1;
                const float v0 = d_0 <= 128 ? p0[r] * sc2 - slope2 * (float)d_0 : -1e30f, v1 = d_1 <= 128 ? p1[r] * sc2 - slope2 * (float)d_1 : -1e30f;
                p0[r] = v0; p1[r] = v1; bm = fmaxf(bm, fmaxf(v0, v1)); }
            bm = fmaxf(bm, __shfl_xor(bm, 32));
            const float mn = fmaxf(mrun[qt], bm), alpha = fexp2(mrun[qt] - mn); mrun[qt] = mn;
            float ls = 0.f;
#pragma unroll
            for (int r = 0; r < 16; ++r) { p0[r] = fexp2(p0[r] - mn); p1[r] = fexp2(p1[r] - mn); ls += p0[r] + p1[r]; }
            lrun[qt] = lrun[qt] * alpha + ls;
#pragma unroll
            for (int dh = 0; dh < 2; ++dh)
#pragma unroll
                for (int r = 0; r < 16; ++r) o[qt][dh][r] *= alpha;
            __builtin_amdgcn_sched_barrier(0);
            bf16x8 pf[4];
            pf[0] = pack8(p0[0], p0[1], p0[2], p0[3], p0[4], p0[5], p0[6], p0[7]); pf[1] = pack8(p0[8], p0[9], p0[10], p0[11], p0[12], p0[13], p0[14], p0[15]);
            pf[2] = pack8(p1[0], p1[1], p1[2], p1[3], p1[4], p1[5], p1[6], p1[7]); pf[3] = pack8(p1[8], p1[9], p1[10], p1[11], p1[12], p1[13], p1[14], p1[15]);
#pragma unroll
            for (int ks = 0; ks < 4; ++ks)
#pragma unroll
                for (int dh = 0; dh < 2; ++dh) {
                    LAS const unsigned char* vp = Vl + (kv * 64 + 32 * dh + r32) * KPITCH + (16 * ks + 4 * hi) * 2;
                    const u32x2 a = *(LAS const u32x2*)vp, c = *(LAS const u32x2*)(vp + 16);
                    const u32x4 vv = {a.x, a.y, c.x, c.y};
                    o[qt][dh] = __builtin_amdgcn_mfma_f32_32x32x16_bf16(__builtin_bit_cast(bf16x8, vv), pf[ks], o[qt][dh], 0, 0, 0);
                }
        }
    }
#undef ATT_LOAD
    LDS_WAIT();
#pragma unroll
    for (int qt = 0; qt < 2; ++qt) { const float lt = lrun[qt] + __shfl_xor(lrun[qt], 32), inv = 1.0f / lt;
#pragma unroll
        for (int dh = 0; dh < 2; ++dh)
#pragma unroll
            for (int r4 = 0; r4 < 4; ++r4) { u32x2 w; w.x = cvt_pk_bf16(o[qt][dh][4 * r4] * inv, o[qt][dh][4 * r4 + 1] * inv); w.y = cvt_pk_bf16(o[qt][dh][4 * r4 + 2] * inv, o[qt][dh][4 * r4 + 3] * inv);
                *(LAS u32x2*)(Yl + (32 * qt + r32) * YPITCH + (h * 64 + 32 * dh + 8 * r4 + 4 * hi) * 2) = w; } }
    __syncthreads();
    rms_store(Yl, g_l, mix + (size_t)row0 * DM);
    __syncthreads();
}

struct LruP { const float *conv_w, *conv_b, *b_rg, *b_ig, *lam, *g_lru; const bf16_t* wg; };
template <int DIR> __device__ __forceinline__ void scan32(const f32x16& A, const f32x16& U, float& c, float& Atot, int hi, float (&hsv)[16]) {
    float Ag[4], Hg[4], oA[4], oH[4], cin[4];
#pragma unroll
    for (int gi = 0; gi < 4; ++gi) { const float a0 = A[4 * gi], a1 = A[4 * gi + 1], a2 = A[4 * gi + 2], a3 = A[4 * gi + 3], u0 = U[4 * gi], u1 = U[4 * gi + 1], u2 = U[4 * gi + 2], u3 = U[4 * gi + 3];
        Ag[gi] = (a0 * a1) * (a2 * a3); float hh;
        if (DIR == 0) { hh = u0; hh = a1 * hh + u1; hh = a2 * hh + u2; hh = a3 * hh + u3; } else { hh = u3; hh = a2 * hh + u2; hh = a1 * hh + u1; hh = a0 * hh + u0; }
        Hg[gi] = hh; oA[gi] = __shfl_xor(Ag[gi], 32); oH[gi] = __shfl_xor(hh, 32); }
#pragma unroll
    for (int g_ = 0; g_ < 4; ++g_) { const int gi = DIR == 0 ? g_ : 3 - g_;
        const float AE = hi ? oA[gi] : Ag[gi], HE = hi ? oH[gi] : Hg[gi], AO = hi ? Ag[gi] : oA[gi], HO = hi ? Hg[gi] : oH[gi];
        float ce, co;
        if (DIR == 0) { ce = c; c = AE * c + HE; co = c; c = AO * c + HO; } else { co = c; c = AO * c + HO; ce = c; c = AE * c + HE; }
        cin[gi] = hi ? co : ce; Atot *= AE * AO; }
#pragma unroll
    for (int gi = 0; gi < 4; ++gi) { float hh = cin[gi];
#pragma unroll
        for (int j_ = 0; j_ < 4; ++j_) { const int j = DIR == 0 ? j_ : 3 - j_; hh = A[4 * gi + j] * hh + U[4 * gi + j]; hsv[4 * gi + j] += hh; } }
}
template <bool FINAL> __device__ __forceinline__ void lru_unit(int cgi, const bf16_t* __restrict__ z, bf16_t* mix, const LruP P, f32x2* agg, LAS unsigned char* lds) {
    const int tid = opaque_tid(), lane = tid & 63, r32 = lane & 31, hi = lane >> 5, w = __builtin_amdgcn_readfirstlane(tid >> 6), c0 = 64 * w;
    const int row0 = cgi * 64, b = row_batch(row0), S = batch_len(b), seq0 = batch_row0(b), t0 = row0 - seq0, ch = t0 >> 6, nch = S >> 6, chunkbase = cgi - ch;
    LAS unsigned char* XC = lds + w * 9216; LAS unsigned char* Yl = lds + 73728;
    {
        const int cc = c0 + lane; const float cb = P.conv_b[cc], w0 = P.conv_w[cc], w1 = P.conv_w[512 + cc], w2 = P.conv_w[1024 + cc], w3 = P.conv_w[1536 + cc];
        const bf16_t* zp = z + (size_t)seq0 * DIN + 768 + cc;
#define XLD(t) (((t) >= 0 && (t) < S) ? bf2f(zp[(size_t)(t) * DIN]) : 0.f)
        float a0 = XLD(t0 - 2), a1 = XLD(t0 - 1), a2 = XLD(t0);
#pragma unroll 16
        for (int t = 0; t < 64; ++t) { const float a3 = XLD(t0 + t + 1); const float xc = cb + w0 * a0 + w1 * a1 + w2 * a2 + w3 * a3;
            *(LAS unsigned short*)(XC + t * KPITCH + lane * 2) = (unsigned short)(cvt_pk_bf16(xc, 0.f) & 0xffffu); a0 = a1; a1 = a2; a2 = a3; }
#undef XLD
        LDS_WAIT();
    }
#pragma unroll 1
    for (int mt = 0; mt < 2; ++mt) {
        const int chn = c0 + 32 * mt + r32;
        float hs[2][16];
#pragma unroll
        for (int s = 0; s < 2; ++s)
#pragma unroll
            for (int r = 0; r < 16; ++r) hs[s][r] = 0.f;
#pragma unroll
        for (int dir = 0; dir < 2; ++dir) {
            __builtin_amdgcn_sched_barrier(0);
            const float brg = P.b_rg[dir * 512 + chn], big = P.b_ig[dir * 512 + chn];
            const float lamv = P.lam[dir * 512 + chn], clam = -8.0f * log1pf(expf(-lamv)) * LOG2E;
            float c = 0.f, Atot = 1.f;
            if (FINAL) {
                if (dir == 0) { for (int j = 0; j < ch; ++j) { const f32x2 ah = agg[((size_t)(chunkbase + j) * 2 + 0) * 512 + chn]; c = ah.x * c + ah.y; } }
                else { for (int j = nch - 1; j > ch; --j) { const f32x2 ah = agg[((size_t)(chunkbase + j) * 2 + 1) * 512 + chn]; c = ah.x * c + ah.y; } }
            }
            const bf16_t* wr_ = P.wg + ((size_t)((dir * 2 + 0) * 8 + w) * 64 + 32 * mt + r32) * 64 + hi * 8;
            const bf16_t* wi_ = P.wg + ((size_t)((dir * 2 + 1) * 8 + w) * 64 + 32 * mt + r32) * 64 + hi * 8;
            bf16x8 bfr[4], bfi[4];
#pragma unroll
            for (int ks = 0; ks < 4; ++ks) { bfr[ks] = *(const bf16x8*)(wr_ + ks * 16); bfi[ks] = *(const bf16x8*)(wi_ + ks * 16); }
#pragma unroll
            for (int si = 0; si < 2; ++si) { const int s = dir ? 1 - si : si;
                __builtin_amdgcn_sched_barrier(0);
                f32x16 accr, acci;
#pragma unroll
                for (int r = 0; r < 16; ++r) { accr[r] = 0.f; acci[r] = 0.f; }
#pragma unroll
                for (int ks = 0; ks < 4; ++ks) { const bf16x8 af = *(LAS const bf16x8*)(XC + (32 * s + r32) * KPITCH + (16 * ks + 8 * hi) * 2);
                    accr = __builtin_amdgcn_mfma_f32_32x32x16_bf16(af, bfr[ks], accr, 0, 0, 0); acci = __builtin_amdgcn_mfma_f32_32x32x16_bf16(af, bfi[ks], acci, 0, 0, 0); }
#pragma unroll
                for (int r = 0; r < 16; ++r) { const float xv = bf2f(*(LAS const unsigned short*)(XC + (32 * s + crow(r, hi)) * KPITCH + (32 * mt + r32) * 2));
                    const float rr = fsigmoid(accr[r] + brg), ii = fsigmoid(acci[r] + big), a = fexp2(rr * clam);
                    accr[r] = a; acci[r] = sqrtf(fmaxf(1.0f - a * a, 0.f)) * ii * xv; }
                if (dir == 0) scan32<0>(accr, acci, c, Atot, hi, hs[s]); else scan32<1>(accr, acci, c, Atot, hi, hs[s]);
            }
            if (!FINAL) { if (hi == 0) agg[((size_t)cgi * 2 + dir) * 512 + chn] = (f32x2){Atot, c}; }
        }
        if (FINAL) {
#pragma unroll
            for (int s = 0; s < 2; ++s) { __builtin_amdgcn_sched_barrier(0);
#pragma unroll
                for (int r = 0; r < 16; ++r) { const int t = 32 * s + crow(r, hi); const float gte = bf2f(z[(size_t)(row0 + t) * DIN + 1280 + chn]);
                    const float ge = gte * frcp(1.0f + fexp2(-LOG2E * 1.5957691216f * (gte + 0.044715f * gte * gte * gte)));
                    *(LAS unsigned short*)(Yl + t * YPITCH + chn * 2) = (unsigned short)(cvt_pk_bf16(hs[s][r] * ge, 0.f) & 0xffffu); } }
        }
    }
    if (FINAL) {
        __syncthreads();
        rms_store(Yl, P.g_lru, mix + (size_t)row0 * DM + 512);
        __syncthreads();
    }
}

#ifndef EN_P0
#define EN_P0 1
#endif
#ifndef EN_P1
#define EN_P1 1
#endif
#ifndef EN_G1
#define EN_G1 1
#endif
#ifndef EN_G2
#define EN_G2 1
#endif
#ifndef EN_G3
#define EN_G3 1
#endif
#ifndef EN_G4
#define EN_G4 1
#endif
#ifndef EN_ATT
#define EN_ATT 1
#endif
#ifndef EN_LRUA
#define EN_LRUA 1
#endif
#ifndef EN_LRUB
#define EN_LRUB 1
#endif
__global__ void __launch_bounds__(512, 2) fwd_megakernel(Args a) {
    extern __shared__ __attribute__((aligned(16))) unsigned char lds_raw[];
    LAS unsigned char* lds = (LAS unsigned char*)lds_raw;
    cg::grid_group grid = cg::this_grid();
    const int G = gridDim.x, bx = blockIdx.x, NGW = G * 8;
#define PHASE_IDS() const int tid = opaque_tid(), lane = tid & 63, wave = __builtin_amdgcn_readfirstlane(tid >> 6), gw = bx * 8 + wave; (void)lane; (void)gw
    unsigned char* ws = a.ws;
    bf16_t* Wt_in = (bf16_t*)(ws + WS_WIN); bf16_t* Wt_out = (bf16_t*)(ws + WS_WOUT); bf16_t* Wt_fi = (bf16_t*)(ws + WS_WFI); bf16_t* Wt_fo = (bf16_t*)(ws + WS_WFO);
    bf16_t* Wg = (bf16_t*)(ws + WS_WG); float* mod = (float*)(ws + WS_MOD); float* shw1 = (float*)(ws + WS_SHW1); float* shw2 = (float*)(ws + WS_SHW2);
    float* rsq1 = (float*)(ws + WS_RSQ1); float* rsq2 = (float*)(ws + WS_RSQ2); f32x2* agg = (f32x2*)(ws + WS_AGG);
    bf16_t* hb = (bf16_t*)(ws + WS_HB); bf16_t* zb = (bf16_t*)(ws + WS_Z); bf16_t* mix = (bf16_t*)(ws + WS_MIX); bf16_t* hid = (bf16_t*)(ws + WS_HID);
    float* xres = a.out;

    if (EN_P0) {
        PHASE_IDS();
        LAS float* vl = (LAS float*)lds; LAS float* red = (LAS float*)(lds + 81920);
        if (bx < 384) {
            for (int i = tid; i < NB * 1024; i += 512) { const int b = i >> 10, k = i & 1023; const float v = b < 4 ? a.in[2][b * 1024 + k] : a.in[3][(b - 4) * 1024 + k];
                vl[k * NB + b] = v * fsigmoid(v); }
            __syncthreads();
            for (int it = bx; it < 384; it += G) { const int l = it / 96, chk = it % 96;
                gemv20_item(a.in[4] + (size_t)l * DM * NMODC, NMODC, chk * 64, vl, red, mod + (size_t)l * NB * NMODC, NMODC, chk * 64, a.in[5] + (size_t)l * NMODC); }
        }
        __syncthreads();
        LAS float* scr = (LAS float*)(lds + wave * 8448);
        constexpr int I_IN = 16 * 56, I_OUT = 16 * 32, I_FI = 16 * 176, I_FO = 44 * 32, I_L = I_IN + I_OUT + I_FI + I_FO;
        for (int it = gw; it < NLAYER * I_L; it += NGW) { const int l = it / I_L; int r = it % I_L;
            if (r < I_IN) { transpose_item<0>(a.in[7] + (size_t)l * DM * DIN, DM, DIN, Wt_in + (size_t)l * DIN * DM, scr, r, lane); continue; } r -= I_IN;
            if (r < I_OUT) { transpose_item<0>(a.in[18] + (size_t)l * DM * DM, DM, DM, Wt_out + (size_t)l * DM * DM, scr, r, lane); continue; } r -= I_OUT;
            if (r < I_FI) { transpose_item<1>(a.in[20] + (size_t)l * DM * NFI, DM, NFI, Wt_fi + (size_t)l * NFI * DM, scr, r, lane); continue; } r -= I_FI;
            transpose_item<0>(a.in[21] + (size_t)l * DFF * DM, DFF, DM, Wt_fo + (size_t)l * DM * DFF, scr, r, lane); }
        for (int i = bx * 512 + tid; i < NLAYER * 2 * 2 * 8 * 64 * 64; i += G * 512) { const int c = i & 63, m = (i >> 6) & 63, blk = (i >> 12) & 7, gate = (i >> 15) & 1, dir = (i >> 16) & 1, l = i >> 17;
            const float* src = gate ? a.in[13] : a.in[11]; const float v = src[((size_t)((l * 2 + dir) * 8 + blk) * 64 + c) * 64 + m];
            Wg[i] = (bf16_t)(cvt_pk_bf16(v, 0.f) & 0xffffu); }
    }
    grid.sync();
    if (EN_P1) {
        PHASE_IDS();
        LAS float* vl = (LAS float*)lds; LAS float* red = (LAS float*)(lds + 81920);
        for (int it = bx; it < NLAYER * 116; it += G) { const int l = it / 116, r = it % 116, which = r >= 28 ? 1 : 0, chk = which ? r - 28 : r;
            const float* src = mod + (size_t)l * NB * NMODC + (which ? 3072 : 0);
            for (int i = tid; i < NB * 1024; i += 512) { const int b = i >> 10, k = i & 1023; vl[k * NB + b] = src[(size_t)b * NMODC + k]; }
            __syncthreads();
            if (!which) gemv20_item(a.in[7] + (size_t)l * DM * DIN, DIN, chk * 64, vl, red, shw1 + (size_t)l * NB * DIN, DIN, chk * 64, nullptr);
            else { const int n0 = chk * 64, sc_ = ((n0 >> 7) & 1) * DFF + (n0 >> 8) * 128 + (n0 & 127);
                gemv20_item(a.in[20] + (size_t)l * DM * NFI, NFI, sc_, vl, red, shw2 + (size_t)l * NB * NFI, NFI, n0, nullptr); }
        }
        for (int row = gw; row < MTOK; row += NGW) {
            const float* xr = row < 16384 ? a.in[0] + (size_t)row * DM : a.in[1] + (size_t)(row - 16384) * DM; const int b = row_batch(row);
            f32x4 v[4]; float ss = 0.f;
#pragma unroll
            for (int j = 0; j < 4; ++j) { v[j] = ((const f32x4*)xr)[64 * j + lane]; ss += (v[j][0] * v[j][0] + v[j][1] * v[j][1]) + (v[j][2] * v[j][2] + v[j][3] * v[j][3]); }
            ss = wave_sum(ss);
#pragma unroll
            for (int j = 0; j < 4; ++j) { const int col = (64 * j + lane) * 4; ((f32x4*)(xres + (size_t)row * DM))[64 * j + lane] = v[j];
                const f32x4 g4 = *(const f32x4*)(a.in[6] + col), s4 = *(const f32x4*)(mod + (size_t)b * NMODC + 1024 + col); const f32x4 hv = v[j] * g4 * (s4 + 1.0f);
                u32x2 w2; w2.x = cvt_pk_bf16(hv[0], hv[1]); w2.y = cvt_pk_bf16(hv[2], hv[3]); *(u32x2*)(hb + (size_t)row * DM + col) = w2; }
            if (lane < 16) rsq1[(size_t)lane * MTOK + row] = lane == 0 ? ss : 0.f;
        }
    }
    grid.sync();
#pragma unroll 1
    for (int l = 0; l < NLAYER; ++l) {
        const float* modl = mod + (size_t)l * NB * NMODC;
        if (EN_G1) {
            pg8::Gemm g{hb, Wt_in + (size_t)l * DIN * DM, MTOK, DIN, DM}; pg8::StaticOrder S; S.init(MTOK, DIN, G, bx);
            pg8::EpiZ E{zb, DIN, rsq1, shw1 + (size_t)l * NB * DIN};
            pg8::gemm_phase<pg8::EpiZ, pg8::StaticOrder, true, true>(lds, g, S, E);
        }
        grid.sync();
        if (EN_ATT || EN_LRUA) {
            LruP P{a.in[9] + (size_t)l * 4 * 512, a.in[10] + (size_t)l * 512, a.in[12] + (size_t)l * 1024, a.in[14] + (size_t)l * 1024, a.in[15] + (size_t)l * 1024, a.in[17] + (size_t)l * 512, Wg + (size_t)l * 2 * 2 * 8 * 64 * 64};
            for (int u = bx; u < 1536; u += G) { if (u < 768) { if (EN_ATT) attn_unit(u, zb, mix, a.in[8] + l * 8, a.in[16] + (size_t)l * 512, lds); } else { if (EN_LRUA) lru_unit<false>(u - 768, zb, mix, P, agg, lds); } }
        }
        grid.sync();
        if (EN_LRUB) {
            LruP P{a.in[9] + (size_t)l * 4 * 512, a.in[10] + (size_t)l * 512, a.in[12] + (size_t)l * 1024, a.in[14] + (size_t)l * 1024, a.in[15] + (size_t)l * 1024, a.in[17] + (size_t)l * 512, Wg + (size_t)l * 2 * 2 * 8 * 64 * 64};
            for (int u = bx; u < 768; u += G) lru_unit<true>(u, zb, mix, P, agg, lds);
        }
        grid.sync();
        if (EN_G2) {
            pg8::Gemm g{mix, Wt_out + (size_t)l * DM * DM, MTOK, DM, DM}; pg8::StaticOrder S; S.init(MTOK, DM, G, bx);
            pg8::EpiRes E{xres, modl + 2048, a.in[19] + (size_t)l * DM, modl + 4096, hb, rsq2};
            pg8::gemm_phase<pg8::EpiRes, pg8::StaticOrder, true, true>(lds, g, S, E);
        }
        grid.sync();
        if (EN_G3) {
            pg8::Gemm g{hb, Wt_fi + (size_t)l * NFI * DM, MTOK, NFI, DM}; pg8::StaticOrder S; S.init(MTOK, NFI, G, bx);
            pg8::EpiSwiGLU E{hid, rsq2, shw2 + (size_t)l * NB * NFI};
            pg8::gemm_phase<pg8::EpiSwiGLU, pg8::StaticOrder, true, true>(lds, g, S, E);
        }
        grid.sync();
        if (EN_G4) {
            const bool last = (l == NLAYER - 1);
            pg8::Gemm g{hid, Wt_fo + (size_t)l * DM * DFF, MTOK, DM, DFF}; pg8::StaticOrder S; S.init(MTOK, DM, G, bx);
            pg8::EpiRes E{xres, modl + 5120, last ? a.in[6] : a.in[6] + (size_t)(l + 1) * DM, last ? modl + 1024 : modl + (size_t)NB * NMODC + 1024, last ? (bf16_t*)nullptr : hb, rsq1};
            pg8::gemm_phase<pg8::EpiRes, pg8::StaticOrder, true, true>(lds, g, S, E);
        }
        grid.sync();
    }
    PHASE_IDS();
    for (int row = gw; row < MTOK; row += NGW) {
        float s = lane < 16 ? rsq1[(size_t)lane * MTOK + row] : 0.f; s = wave_sum(s);
        const float rs = rsqrtf(s * (1.0f / DM) + EPS);
        f32x4* xr = (f32x4*)(xres + (size_t)row * DM);
#pragma unroll
        for (int j = 0; j < 4; ++j) { const f32x4 v = xr[64 * j + lane], g4 = ((const f32x4*)a.in[22])[64 * j + lane]; xr[64 * j + lane] = v * rs * g4; }
    }
}

extern "C" void kernel_launch(void* const* d_in, const int* in_sizes, int n_in, void* d_out, int out_size, void* d_ws, size_t ws_size, hipStream_t stream) {
    static int grid = 0;
    if (grid == 0) {
        int dev = 0, cus = 0, per_cu = 0;
        (void)hipGetDevice(&dev);
        (void)hipDeviceGetAttribute(&cus, hipDeviceAttributeMultiprocessorCount, dev);
        (void)hipFuncSetAttribute((const void*)fwd_megakernel, hipFuncAttributeMaxDynamicSharedMemorySize, LDS_BYTES);
        (void)hipOccupancyMaxActiveBlocksPerMultiprocessor(&per_cu, (const void*)fwd_megakernel, 512, LDS_BYTES);
        (void)hipGetLastError();
        grid = cus > 0 ? cus : 256;
        if (n_in != 23 || ws_size < WS_END) { fprintf(stderr, "kernel_launch: unexpected n_in %d / ws %zu\n", n_in, ws_size); }
    }
    Args a{};
    for (int i = 0; i < 23; ++i) a.in[i] = (const float*)d_in[i];
    a.out = (float*)d_out; a.ws = (unsigned char*)d_ws;
    void* args[] = {&a};
    hipError_t e = hipLaunchCooperativeKernel((const void*)fwd_megakernel, dim3(grid), dim3(512), args, LDS_BYTES, stream);
    if (e != hipSuccess) fprintf(stderr, "cooperative launch failed: %s (grid %d)\n", hipGetErrorString(e), grid);
}
```

```cpp
#include <hip/hip_runtime.h>
#include <hip/hip_cooperative_groups.h>
#include <cstdio>
#include <cstdint>
namespace cg = cooperative_groups;

constexpr int MTOK = 49152, DM = 1024, DIN = 1792, DFF = 2816, NFI = 5632, NLAYER = 4, NB = 20, NMODC = 6144;
constexpr float EPS = 1e-6f, LOG2E = 1.4426950408889634f;
__device__ __forceinline__ int row_batch(int row) { return row < 16384 ? (row >> 12) : 4 + ((row - 16384) >> 11); }
__device__ __forceinline__ int batch_row0(int b) { return b < 4 ? b * 4096 : 16384 + (b - 4) * 2048; }
__device__ __forceinline__ int batch_len(int b) { return b < 4 ? 4096 : 2048; }
namespace pg8 {
#define PG8_LAS __attribute__((address_space(3)))
typedef unsigned short bf16_t;
typedef short bf16x8 __attribute__((ext_vector_type(8)));
typedef float f32x4 __attribute__((ext_vector_type(4)));
typedef unsigned u32x4 __attribute__((ext_vector_type(4)));
constexpr int BM = 256, BK = 64, HALF = 128, HTB = HALF * BK * 2  , STAGE_BYTES = 8 * HTB, NXCD = 8, WGM = 8;

__host__ __device__ __forceinline__ int lds_byte(int r, int c) { const int st = (r >> 4) * 2 + (c >> 5), rr = r & 15, cc = c & 31, ob = rr * 64 + cc * 2; return st * 1024 + (ob ^ (((ob >> 9) & 1) << 5)); }
__host__ __device__ __forceinline__ void stage_rc(int b, int& R, int& C) { const int st = b / 1024, sb = b % 1024, swz = sb ^ (((sb >> 9) & 1) << 5); R = (st >> 1) * 16 + swz / 64; C = (st & 1) * 32 + (swz % 64) / 2; }
__host__ __device__ __forceinline__ int perm32(int rho) { const int n = rho >> 4, i = rho & 15; return 8 * (i >> 2) + 4 * n + (i & 3); }

struct Unit { int pm, pn; };
struct Gemm { const bf16_t* A; const bf16_t* Bt; int M, N, K; };

struct StaticOrder {
    int nM, nN, nwg, G, c;
    __host__ __device__ void init(int M, int N, int G_, int c_) { nM = M / BM; nN = N / BM; nwg = nM * nN; G = G_; c = c_; }
    __host__ __device__ bool next(int i, Unit& u) const {
        const long L = (long)i * G + c; if (L >= nwg) return false;
        int wgid = (int)L; { const int q = nwg / NXCD, r = nwg % NXCD, xcd = wgid % NXCD, off = wgid / NXCD; wgid = (xcd < r ? xcd * (q + 1) : r * (q + 1) + (xcd - r) * q) + off; }
        const int nig = WGM * nN, gid = wgid / nig, fm = gid * WGM, gsz = (nM - fm) < WGM ? (nM - fm) : WGM;
        u.pm = fm + ((wgid % nig) % gsz); u.pn = (wgid % nig) / gsz; return true;
    }
    __device__ __forceinline__ void a_ready(const Unit&) const {}
    __device__ __forceinline__ void done(const Unit&) const {}
};

__device__ __forceinline__ unsigned cvt_pk_bf16(float lo, float hi) { unsigned r; asm("v_cvt_pk_bf16_f32 %0, %1, %2" : "=v"(r) : "v"(lo), "v"(hi)); return r; }
__device__ __forceinline__ void rows_rstd(const float* rowsq, int row0, int fq, float (&rs)[8]) {
    float part[8][4];
#pragma unroll
    for (int g = 0; g < 8; ++g)
#pragma unroll
        for (int p = 0; p < 4; ++p) part[g][p] = rowsq[(size_t)(fq * 4 + p) * MTOK + row0 + (g >> 2) * HALF + (g & 3) * 16];
    asm volatile("" ::: "memory");
#pragma unroll
    for (int g = 0; g < 8; ++g) { float s = (part[g][0] + part[g][1]) + (part[g][2] + part[g][3]); s += __shfl_xor(s, 16); s += __shfl_xor(s, 32); rs[g] = rsqrtf(s * (1.0f / DM) + EPS); }
}
struct EpiZ {
    static constexpr bool PERM = true, AFTER_DRAIN = false;
    bf16_t* O; int ldc; const float* rowsq; const float* shw;
    __device__ __forceinline__ void operator()(const f32x4 (&acc)[2][2][4][2], const Unit& u, int wr, int wc, int fr, int fq) const {
        const int row0 = u.pm * BM + wr * 64 + fr; const int b = row_batch(u.pm * BM);
        const int col0 = u.pn * BM + wc * 32 + 8 * fq;
        f32x4 bv[2][2];
#pragma unroll
        for (int bj = 0; bj < 2; ++bj)
#pragma unroll
            for (int n = 0; n < 2; ++n) bv[bj][n] = *(const f32x4*)(shw + (size_t)b * ldc + col0 + bj * HALF + 4 * n);
        float rsv[8]; rows_rstd(rowsq, row0, fq, rsv);
#pragma unroll
        for (int ai = 0; ai < 2; ++ai)
#pragma unroll
            for (int m = 0; m < 4; ++m) { const int row = row0 + ai * HALF + m * 16; const float rs = rsv[ai * 4 + m];
                bf16_t* rowp = O + (size_t)row * ldc + col0;
#pragma unroll
                for (int bj = 0; bj < 2; ++bj) { const f32x4 v0 = acc[ai][bj][m][0] * rs + bv[bj][0], v1 = acc[ai][bj][m][1] * rs + bv[bj][1];
                    u32x4 w; w.x = cvt_pk_bf16(v0[0], v0[1]); w.y = cvt_pk_bf16(v0[2], v0[3]); w.z = cvt_pk_bf16(v1[0], v1[1]); w.w = cvt_pk_bf16(v1[2], v1[3]);
                    *(u32x4*)(rowp + bj * HALF) = w; } }
    }
};
struct EpiSwiGLU {
    static constexpr bool PERM = true, AFTER_DRAIN = false;
    bf16_t* O; const float* rowsq; const float* shw;
    __device__ __forceinline__ void operator()(const f32x4 (&acc)[2][2][4][2], const Unit& u, int wr, int wc, int fr, int fq) const {
        const int row0 = u.pm * BM + wr * 64 + fr; const int b = row_batch(u.pm * BM);
        const int col0 = u.pn * BM + wc * 32 + 8 * fq, ocol = u.pn * HALF + wc * 32 + 8 * fq;
        f32x4 bv[2][2];
#pragma unroll
        for (int bj = 0; bj < 2; ++bj)
#pragma unroll
            for (int n = 0; n < 2; ++n) bv[bj][n] = *(const f32x4*)(shw + (size_t)b * NFI + col0 + bj * HALF + 4 * n);
        float rsv[8]; rows_rstd(rowsq, row0, fq, rsv);
#pragma unroll
        for (int ai = 0; ai < 2; ++ai)
#pragma unroll
            for (int m = 0; m < 4; ++m) { const int row = row0 + ai * HALF + m * 16; const float rs = rsv[ai * 4 + m];
                float o[8];
#pragma unroll
                for (int n = 0; n < 2; ++n) { const f32x4 g = acc[ai][0][m][n] * rs + bv[0][n], uu = acc[ai][1][m][n] * rs + bv[1][n];
#pragma unroll
                    for (int j = 0; j < 4; ++j) { const float s = __builtin_amdgcn_rcpf(1.0f + __builtin_amdgcn_exp2f(-LOG2E * g[j])); o[4 * n + j] = g[j] * s * uu[j]; } }
                u32x4 w; w.x = cvt_pk_bf16(o[0], o[1]); w.y = cvt_pk_bf16(o[2], o[3]); w.z = cvt_pk_bf16(o[4], o[5]); w.w = cvt_pk_bf16(o[6], o[7]);
                *(u32x4*)(O + (size_t)row * DFF + ocol) = w; }
    }
};
struct EpiRes {
    static constexpr bool PERM = true, AFTER_DRAIN = false;
    float* x; const float* gt; const float* gn; const float* sc; bf16_t* hb; float* rowsq_out;
    __device__ __forceinline__ void operator()(const f32x4 (&acc)[2][2][4][2], const Unit& u, int wr, int wc, int fr, int fq) const {
        const int row0 = u.pm * BM + wr * 64 + fr; const int b = row_batch(u.pm * BM);
        const int col0 = u.pn * BM + wc * 32 + 8 * fq;
        f32x4 gv[2][2], mv[2][2];
#pragma unroll
        for (int bj = 0; bj < 2; ++bj)
#pragma unroll
            for (int n = 0; n < 2; ++n) { const int c = col0 + bj * HALF + 4 * n; gv[bj][n] = *(const f32x4*)(gt + (size_t)b * NMODC + c);
                if (hb) { const f32x4 g4 = *(const f32x4*)(gn + c), s4 = *(const f32x4*)(sc + (size_t)b * NMODC + c); mv[bj][n] = g4 * (s4 + 1.0f); } else mv[bj][n] = (f32x4){0.f, 0.f, 0.f, 0.f}; }
#pragma unroll
        for (int ap = 0; ap < 4; ++ap) { const int ai = ap >> 1, m0 = (ap & 1) * 2;
            f32x4 xv[2][2][2];
#pragma unroll
            for (int mm = 0; mm < 2; ++mm)
#pragma unroll
                for (int bj = 0; bj < 2; ++bj)
#pragma unroll
                    for (int n = 0; n < 2; ++n) xv[mm][bj][n] = *(const f32x4*)(x + (size_t)(row0 + ai * HALF + (m0 + mm) * 16) * DM + col0 + bj * HALF + 4 * n);
            asm volatile("" ::: "memory");
#pragma unroll
            for (int mm = 0; mm < 2; ++mm) { const int m = m0 + mm; const int row = row0 + ai * HALF + m * 16; float* xp = x + (size_t)row * DM + col0; float ss = 0.f;
#pragma unroll
                for (int bj = 0; bj < 2; ++bj) { f32x4 xn[2];
#pragma unroll
                    for (int n = 0; n < 2; ++n) { xn[n] = xv[mm][bj][n] + gv[bj][n] * acc[ai][bj][m][n];
                        *(f32x4*)(xp + bj * HALF + 4 * n) = xn[n]; ss += (xn[n][0] * xn[n][0] + xn[n][1] * xn[n][1]) + (xn[n][2] * xn[n][2] + xn[n][3] * xn[n][3]); }
                    if (hb) { const f32x4 h0 = xn[0] * mv[bj][0], h1 = xn[1] * mv[bj][1];
                        u32x4 w; w.x = cvt_pk_bf16(h0[0], h0[1]); w.y = cvt_pk_bf16(h0[2], h0[3]); w.z = cvt_pk_bf16(h1[0], h1[1]); w.w = cvt_pk_bf16(h1[2], h1[3]);
                        *(u32x4*)(hb + (size_t)row * DM + col0 + bj * HALF) = w; } }
                ss += __shfl_xor(ss, 16); ss += __shfl_xor(ss, 32);
                if (fq == 0) rowsq_out[(size_t)(u.pn * 4 + wc) * MTOK + row] = ss; }
        }
    }
};

template <class Epi, class Sched, bool ALIGN_EPI = false, bool SP2 = false>
__device__ __forceinline__ void gemm_phase(PG8_LAS unsigned char* lds, const Gemm g, const Sched& S, const Epi& E) {
    int tid_ = threadIdx.x; asm volatile("" : "+v"(tid_)); const int tid = tid_, wid = __builtin_amdgcn_readfirstlane(tid >> 6), lane = tid & 63, wr = wid >> 2, wc = wid & 3, fr = lane & 15, fq = lane >> 4;
    const int K = g.K, nt = K / BK;
    unsigned voffA[2], voffB[2];
#pragma unroll
    for (int i = 0; i < 2; ++i) { int R, C; stage_rc(tid * 16 + i * 8192, R, C); const int Rb = Epi::PERM ? ((R & ~31) + perm32(R & 31)) : R;
        voffA[i] = (unsigned)(R * K + C) * 2u; voffB[i] = (unsigned)(Rb * K + C) * 2u; }
    const size_t kstep = (size_t)(BK * 2);
    const size_t hstep = (size_t)HALF * K * 2;
    const size_t tstep = 2 * hstep;
    const unsigned ldsw = (unsigned)wid * 1024u;
    const int aoff = lds_byte(wr * 64 + fr, fq * 8), boff = lds_byte(wc * 32 + fr, fq * 8);
#define PG8_SA(b, h) (((b) * 2 + (h)) * HTB)
#define PG8_SB(b, h) ((4 + (b) * 2 + (h)) * HTB)
#define PG8_STAGE(bufoff, gbase, voff) do { _Pragma("unroll") for (int _i = 0; _i < 2; ++_i) \
        __builtin_amdgcn_global_load_lds((const unsigned*)((const char*)(gbase) + (voff)[_i]), (PG8_LAS unsigned*)(lds + (bufoff) + ldsw + _i * 8192), 16, 0, 0); } while (0)
#define PG8_LDA(dst, b, h) do { _Pragma("unroll") for (int m = 0; m < 4; ++m) _Pragma("unroll") for (int k = 0; k < 2; ++k) dst[m][k] = *(const PG8_LAS bf16x8*)(lds + PG8_SA(b, h) + aoff + m * 2048 + k * 1024); } while (0)
#define PG8_LDB(dst, b, h) do { _Pragma("unroll") for (int n = 0; n < 2; ++n) _Pragma("unroll") for (int k = 0; k < 2; ++k) dst[n][k] = *(const PG8_LAS bf16x8*)(lds + PG8_SB(b, h) + boff + n * 2048 + k * 1024); } while (0)
#define PG8_MMA(ai, bj, At, Bt) do { __builtin_amdgcn_s_setprio(1); _Pragma("unroll") for (int m = 0; m < 4; ++m) _Pragma("unroll") for (int n = 0; n < 2; ++n) _Pragma("unroll") for (int k = 0; k < 2; ++k) \
        acc[ai][bj][m][n] = __builtin_amdgcn_mfma_f32_16x16x32_bf16(Bt[n][k], At[m][k], acc[ai][bj][m][n], 0, 0, 0); __builtin_amdgcn_s_setprio(0); } while (0)
#define PG8_WAIT_V(n) asm volatile("s_waitcnt vmcnt(" #n ")" ::: "memory")
#define PG8_WAIT_L(n) asm volatile("s_waitcnt lgkmcnt(" #n ")" ::: "memory")
#define PG8_BAR __builtin_amdgcn_s_barrier()
#define PG8_SCHED __builtin_amdgcn_sched_barrier(0)
    Unit cur, nxt; int ui = 0;
    if (!S.next(0, cur)) return;
    f32x4 acc[2][2][4][2];
#pragma unroll
    for (int a = 0; a < 2; ++a)
#pragma unroll
        for (int b = 0; b < 2; ++b)
#pragma unroll
            for (int m = 0; m < 4; ++m)
#pragma unroll
                for (int n = 0; n < 2; ++n) acc[a][b][m][n] = (f32x4){0.f, 0.f, 0.f, 0.f};
    bf16x8 At[4][2], B0[2][2], B1[2][2];
    const char* cA = (const char*)g.A + (size_t)cur.pm * tstep; const char* cB = (const char*)g.Bt + (size_t)cur.pn * tstep;
    S.a_ready(cur);
    if constexpr (SP2) {
        PG8_STAGE(PG8_SB(0, 0), cB, voffB); PG8_STAGE(PG8_SB(0, 1), cB + hstep, voffB); PG8_STAGE(PG8_SA(0, 0), cA, voffA); PG8_STAGE(PG8_SA(0, 1), cA + hstep, voffA);
        if (wr == 1) PG8_BAR;
        PG8_WAIT_V(2); PG8_BAR;
        PG8_STAGE(PG8_SB(1, 0), cB + kstep, voffB); PG8_STAGE(PG8_SA(1, 0), cA + kstep, voffA); PG8_STAGE(PG8_SB(1, 1), cB + hstep + kstep, voffB);
        PG8_WAIT_V(6); PG8_BAR;
    } else {
        PG8_STAGE(PG8_SB(0, 0), cB, voffB); PG8_STAGE(PG8_SA(0, 0), cA, voffA); PG8_STAGE(PG8_SB(0, 1), cB + hstep, voffB); PG8_STAGE(PG8_SA(0, 1), cA + hstep, voffA);
        if (wr == 1) PG8_BAR;
        PG8_WAIT_V(4); PG8_BAR;
        PG8_STAGE(PG8_SB(1, 0), cB + kstep, voffB); PG8_STAGE(PG8_SA(1, 0), cA + kstep, voffA); PG8_STAGE(PG8_SB(1, 1), cB + hstep + kstep, voffB);
        PG8_WAIT_V(6); PG8_BAR;
    }
    for (;;) {
        const bool has_next = S.next(ui + 1, nxt);
        const char* nA = has_next ? (const char*)g.A + (size_t)nxt.pm * tstep : cA; const char* nB = has_next ? (const char*)g.Bt + (size_t)nxt.pn * tstep : cB;
        for (int t = 0; t < nt; t += 2) {
            const bool last = (t == nt - 2);
            const char* a1 = cA + (size_t)(t + 1) * kstep;
            const char* a2 = last ? nA : cA + (size_t)(t + 2) * kstep; const char* b2 = last ? nB : cB + (size_t)(t + 2) * kstep;
            const char* a3 = a2 + kstep; const char* b3 = b2 + kstep;
            if (last && has_next) S.a_ready(nxt);
            if constexpr (SP2) {
            PG8_LDB(B0, 0, 0); PG8_LDB(B1, 0, 1); PG8_SCHED; PG8_LDA(At, 0, 0); PG8_STAGE(PG8_SA(1, 1), a1 + hstep, voffA);
            PG8_WAIT_V(8); PG8_WAIT_L(0); PG8_BAR; PG8_MMA(0, 0, At, B0); PG8_MMA(0, 1, At, B1); PG8_BAR; PG8_SCHED;
            PG8_LDA(At, 0, 1); PG8_STAGE(PG8_SB(0, 0), b2, voffB); PG8_STAGE(PG8_SB(0, 1), b2 + hstep, voffB); PG8_STAGE(PG8_SA(0, 0), a2, voffA);
            PG8_WAIT_V(8); PG8_WAIT_L(0); PG8_BAR; PG8_MMA(1, 0, At, B0); PG8_MMA(1, 1, At, B1); PG8_BAR; PG8_SCHED;
            PG8_LDB(B0, 1, 0); PG8_LDB(B1, 1, 1); PG8_SCHED; PG8_LDA(At, 1, 0); PG8_STAGE(PG8_SA(0, 1), a2 + hstep, voffA);
            PG8_WAIT_V(8); PG8_WAIT_L(0); PG8_BAR; PG8_MMA(0, 0, At, B0); PG8_MMA(0, 1, At, B1); PG8_BAR; PG8_SCHED;
            PG8_LDA(At, 1, 1); PG8_STAGE(PG8_SB(1, 0), b3, voffB); PG8_STAGE(PG8_SB(1, 1), b3 + hstep, voffB); PG8_STAGE(PG8_SA(1, 0), a3, voffA);
            PG8_WAIT_V(8); PG8_WAIT_L(0); PG8_BAR; PG8_MMA(1, 0, At, B0); PG8_MMA(1, 1, At, B1); PG8_BAR; PG8_SCHED;
            } else {
            PG8_LDB(B0, 0, 0); PG8_SCHED; PG8_LDA(At, 0, 0); PG8_STAGE(PG8_SA(1, 1), a1 + hstep, voffA);
            PG8_WAIT_L(8); PG8_BAR; PG8_WAIT_L(0); PG8_MMA(0, 0, At, B0); PG8_BAR; PG8_SCHED;
            PG8_LDB(B1, 0, 1); PG8_STAGE(PG8_SB(0, 0), b2, voffB);
            PG8_BAR; PG8_WAIT_L(0); PG8_MMA(0, 1, At, B1); PG8_BAR;
            PG8_LDA(At, 0, 1); PG8_STAGE(PG8_SA(0, 0), a2, voffA);
            PG8_BAR; PG8_WAIT_L(0); PG8_MMA(1, 0, At, B0); PG8_BAR; PG8_SCHED;
            PG8_STAGE(PG8_SB(0, 1), b2 + hstep, voffB);
            PG8_WAIT_V(6); PG8_BAR; PG8_MMA(1, 1, At, B1); PG8_BAR;
            PG8_LDB(B0, 1, 0); PG8_SCHED; PG8_LDA(At, 1, 0); PG8_STAGE(PG8_SA(0, 1), a2 + hstep, voffA);
            PG8_WAIT_L(8); PG8_BAR; PG8_WAIT_L(0); PG8_MMA(0, 0, At, B0); PG8_BAR; PG8_SCHED;
            PG8_LDB(B1, 1, 1); PG8_STAGE(PG8_SB(1, 0), b3, voffB);
            PG8_BAR; PG8_WAIT_L(0); PG8_MMA(0, 1, At, B1); PG8_BAR;
            PG8_LDA(At, 1, 1); PG8_STAGE(PG8_SA(1, 0), a3, voffA);
            PG8_BAR; PG8_WAIT_L(0); PG8_MMA(1, 0, At, B0); PG8_BAR; PG8_SCHED;
            PG8_STAGE(PG8_SB(1, 1), b3 + hstep, voffB);
            PG8_WAIT_V(6); PG8_BAR; PG8_MMA(1, 1, At, B1); PG8_BAR;
            }
        }
        if constexpr (ALIGN_EPI) { if (wr == 0) PG8_BAR; }
        if constexpr (!Epi::AFTER_DRAIN) { E(acc, cur, wr, wc, fr, fq); S.done(cur); }
        if (!has_next) break;
#pragma unroll
        for (int a = 0; a < 2; ++a)
#pragma unroll
            for (int b = 0; b < 2; ++b)
#pragma unroll
                for (int m = 0; m < 4; ++m)
#pragma unroll
                    for (int n = 0; n < 2; ++n) acc[a][b][m][n] = (f32x4){0.f, 0.f, 0.f, 0.f};
        cur = nxt; cA = nA; cB = nB; ++ui;
        if constexpr (ALIGN_EPI) { if (wr == 1) PG8_BAR; }
    }
    PG8_WAIT_V(0);
    if constexpr (!ALIGN_EPI) { if (wr == 0) PG8_BAR; }
    PG8_BAR;
    if constexpr (Epi::AFTER_DRAIN) { E.fused(acc, cur, wr, wc, fr, fq, lds, wid, lane); S.done(cur); }
#undef PG8_SA
#undef PG8_SB
#undef PG8_STAGE
#undef PG8_LDA
#undef PG8_LDB
#undef PG8_MMA
#undef PG8_WAIT_V
#undef PG8_WAIT_L
#undef PG8_BAR
#undef PG8_SCHED
}
}

#define LAS __attribute__((address_space(3)))
typedef unsigned short bf16_t;
typedef short bf16x8 __attribute__((ext_vector_type(8)));
typedef float f32x4 __attribute__((ext_vector_type(4)));
typedef float f32x2 __attribute__((ext_vector_type(2)));
typedef float f32x16 __attribute__((ext_vector_type(16)));
typedef unsigned u32x4 __attribute__((ext_vector_type(4)));
typedef unsigned u32x2 __attribute__((ext_vector_type(2)));
#define LDS_WAIT() asm volatile("s_waitcnt lgkmcnt(0)" ::: "memory")
__device__ __forceinline__ int opaque_tid() { int t = threadIdx.x; asm volatile("" : "+v"(t)); return t; }
using pg8::cvt_pk_bf16;
__device__ __forceinline__ float bf2f(unsigned v16) { return __uint_as_float(v16 << 16); }
__device__ __forceinline__ float fexp2(float x) { return __builtin_amdgcn_exp2f(x); }
__device__ __forceinline__ float frcp(float x) { return __builtin_amdgcn_rcpf(x); }
__device__ __forceinline__ float fsigmoid(float x) { return frcp(1.0f + fexp2(-LOG2E * x)); }
__device__ __forceinline__ float wave_sum(float v) {
#pragma unroll
    for (int o = 1; o < 64; o <<= 1) v += __shfl_xor(v, o);
    return v;
}

constexpr size_t MiB = 1u << 20;
constexpr size_t WS_WIN = 1 * MiB, WS_WOUT = 15 * MiB, WS_WFI = 23 * MiB, WS_WFO = 67 * MiB, WS_WG = 89 * MiB, WS_MOD = 90 * MiB, WS_SHW1 = 92 * MiB, WS_SHW2 = 93 * MiB,
                 WS_RSQ1 = 95 * MiB, WS_RSQ2 = 98 * MiB, WS_AGG = 101 * MiB, WS_HB = 108 * MiB, WS_Z = 204 * MiB, WS_MIX = 372 * MiB, WS_HID = 204 * MiB, WS_END = 468 * MiB;
constexpr int LDS_BYTES = 147456;

struct Args { const float* in[23]; float* out; unsigned char* ws; int pad0, pad1; };

template <int MODE> __device__ __forceinline__ void transpose_item(const float* W, int K, int N, bf16_t* WT, LAS float* scr, int item, int lane) {
    const int nblk = N / 32, kb = item / nblk, nb = item % nblk, k0 = 64 * kb, n0 = 32 * nb;
#pragma unroll 8
    for (int i = 0; i < 32; ++i) { const int kk = 2 * i + (lane >> 5); scr[kk * 33 + (lane & 31)] = W[(size_t)(k0 + kk) * N + n0 + (lane & 31)]; }
    LDS_WAIT();
    int drow0 = n0;
    if (MODE == 1) { const int half = n0 >= DFF ? 1 : 0; const int j = n0 - half * DFF; drow0 = (j >> 7) * 256 + half * 128 + (j & 127); }
    const int c = lane & 7;
#pragma unroll
    for (int j = 0; j < 4; ++j) { const int n = (lane >> 3) + 8 * j; const LAS float* s = scr + (8 * c) * 33 + n;
        u32x4 o; o.x = cvt_pk_bf16(s[0 * 33], s[1 * 33]); o.y = cvt_pk_bf16(s[2 * 33], s[3 * 33]); o.z = cvt_pk_bf16(s[4 * 33], s[5 * 33]); o.w = cvt_pk_bf16(s[6 * 33], s[7 * 33]);
        *(u32x4*)(WT + (size_t)(drow0 + n) * K + k0 + 8 * c) = o; }
    LDS_WAIT();
}

__device__ __forceinline__ void gemv20_item(const float* W, int ldw, int srccol0, LAS const float* vl, LAS float* red, float* out, int ostride, int dstcol0, const float* bias) {
    const int tid = opaque_tid(), cl = tid & 63, kg = tid >> 6;
    float acc[NB];
#pragma unroll
    for (int b = 0; b < NB; ++b) acc[b] = 0.f;
    const float* wp = W + (size_t)(kg * 128) * ldw + srccol0 + cl;
    LAS const f32x4* vp = (LAS const f32x4*)(vl + kg * 128 * NB);
#pragma unroll 4
    for (int k = 0; k < 128; ++k) { const float w = wp[(size_t)k * ldw];
#pragma unroll
        for (int q = 0; q < 5; ++q) { const f32x4 v = vp[k * 5 + q]; acc[4 * q] += v[0] * w; acc[4 * q + 1] += v[1] * w; acc[4 * q + 2] += v[2] * w; acc[4 * q + 3] += v[3] * w; } }
#pragma unroll
    for (int b = 0; b < NB; ++b) red[(kg * NB + b) * 64 + cl] = acc[b];
    __syncthreads();
    for (int o = tid; o < NB * 64; o += 512) { const int b = o >> 6, c = o & 63; float s = 0.f;
#pragma unroll
        for (int g = 0; g < 8; ++g) s += red[(g * NB + b) * 64 + c];
        if (bias) s += bias[dstcol0 + c];
        out[(size_t)b * ostride + dstcol0 + c] = s; }
    __syncthreads();
}

constexpr int YPITCH = 1040;
__device__ __forceinline__ void rms_store(LAS const unsigned char* Yl, const float* g, bf16_t* dst) {
    const int tid = opaque_tid(), tok = tid >> 3, sub = tid & 7;
    u32x4 v[8]; float ss = 0.f;
#pragma unroll
    for (int j = 0; j < 8; ++j) { v[j] = *(LAS const u32x4*)(Yl + tok * YPITCH + (j * 8 + sub) * 16);
#pragma unroll
        for (int e = 0; e < 4; ++e) { const float a = bf2f(v[j][e] & 0xffffu), b = __uint_as_float(v[j][e] & 0xffff0000u); ss += a * a + b * b; } }
    ss += __shfl_xor(ss, 1); ss += __shfl_xor(ss, 2); ss += __shfl_xor(ss, 4);
    const float rs = rsqrtf(ss * (1.0f / 512.0f) + EPS);
#pragma unroll
    for (int j = 0; j < 8; ++j) { const int c = (j * 8 + sub) * 8; const f32x4 g0 = *(const f32x4*)(g + c), g1 = *(const f32x4*)(g + c + 4);
        u32x4 o;
        o.x = cvt_pk_bf16(bf2f(v[j][0] & 0xffffu) * rs * g0[0], __uint_as_float(v[j][0] & 0xffff0000u) * rs * g0[1]);
        o.y = cvt_pk_bf16(bf2f(v[j][1] & 0xffffu) * rs * g0[2], __uint_as_float(v[j][1] & 0xffff0000u) * rs * g0[3]);
        o.z = cvt_pk_bf16(bf2f(v[j][2] & 0xffffu) * rs * g1[0], __uint_as_float(v[j][2] & 0xffff0000u) * rs * g1[1]);
        o.w = cvt_pk_bf16(bf2f(v[j][3] & 0xffffu) * rs * g1[2], __uint_as_float(v[j][3] & 0xffff0000u) * rs * g1[3]);
        *(u32x4*)(dst + (size_t)tok * DM + c) = o; }
}

__device__ __forceinline__ int crow(int r, int hi) { return (r & 3) + 8 * (r >> 2) + 4 * hi; }
__device__ __forceinline__ bf16x8 pack8(float a0, float a1, float a2, float a3, float a4, float a5, float a6, float a7) {
    u32x4 w; w.x = cvt_pk_bf16(a0, a1); w.y = cvt_pk_bf16(a2, a3); w.z = cvt_pk_bf16(a4, a5); w.w = cvt_pk_bf16(a6, a7); return __builtin_bit_cast(bf16x8, w);
}

constexpr int KPITCH = 144;
__device__ __forceinline__ void attn_unit(int cgi, const bf16_t* __restrict__ z, bf16_t* mix, const float* sink_l, const float* g_l, LAS unsigned char* lds) {
    const int tid = opaque_tid(), lane = tid & 63, r32 = lane & 31, hi = lane >> 5, h = __builtin_amdgcn_readfirstlane(tid >> 6), kv = h >> 2;
    const int row0 = cgi * 64, b = row_batch(row0), S = batch_len(b), seq0 = batch_row0(b), t0 = row0 - seq0, qb = t0 >> 6, nkb = S >> 6;
    const int kb_lo = qb - 2 < 0 ? 0 : qb - 2, kb_hi = qb + 2 > nkb - 1 ? nkb - 1 : qb + 2;
    LAS unsigned char* Kl = lds; LAS unsigned char* Vl = lds + 18432; LAS unsigned char* Yl = lds + 36864;
#pragma unroll
    for (int qt = 0; qt < 2; ++qt)
#pragma unroll
        for (int d0 = 0; d0 < 4; ++d0) { const u32x4 qv = *(const u32x4*)(z + (size_t)(row0 + 32 * qt + r32) * DIN + h * 64 + d0 * 16 + hi * 8);
            *(LAS u32x4*)(Yl + (32 * qt + r32) * YPITCH + (h * 64 + d0 * 16 + hi * 8) * 2) = qv; }
    LDS_WAIT();
    const float slope2 = fexp2(-(float)(h + 1)) * LOG2E, sc2 = 0.125f * LOG2E;
    float mrun[2], lrun[2]; f32x16 o[2][2];
#pragma unroll
    for (int qt = 0; qt < 2; ++qt) { mrun[qt] = sink_l[h] * LOG2E; lrun[qt] = hi ? 0.f : 1.f;
#pragma unroll
        for (int dh = 0; dh < 2; ++dh)
#pragma unroll
            for (int r = 0; r < 16; ++r) o[qt][dh][r] = 0.f; }
    const int s_key = tid >> 3, s_dch = tid & 7, v_kv = tid >> 8, v_dch = (tid >> 5) & 7, v_pair = tid & 31;
    u32x4 kreg[2], vreg[2];
#define ATT_LOAD(kb) do { const int krow = seq0 + (kb) * 64; \
        _Pragma("unroll") for (int i = 0; i < 2; ++i) { kreg[i] = *(const u32x4*)(z + (size_t)(krow + s_key) * DIN + 512 + i * 64 + s_dch * 8); \
            vreg[i] = *(const u32x4*)(z + (size_t)(krow + 2 * v_pair + i) * DIN + 640 + v_kv * 64 + v_dch * 8); } } while (0)
    ATT_LOAD(kb_lo);
    for (int kb = kb_lo; kb <= kb_hi; ++kb) {
        __syncthreads();
#pragma unroll
        for (int i = 0; i < 2; ++i) *(LAS u32x4*)(Kl + (i * 64 + s_key) * KPITCH + s_dch * 16) = kreg[i];
#pragma unroll
        for (int e = 0; e < 8; ++e) { const unsigned w0 = vreg[0][e >> 1], w1 = vreg[1][e >> 1];
            const unsigned lo = (e & 1) ? (w0 >> 16) : (w0 & 0xffffu), hh = (e & 1) ? (w1 & 0xffff0000u) : (w1 << 16);
            *(LAS unsigned*)(Vl + (v_kv * 64 + v_dch * 8 + e) * KPITCH + v_pair * 4) = lo | hh; }
        __syncthreads();
        if (kb < kb_hi) ATT_LOAD(kb + 1);
#pragma unroll
        for (int qt = 0; qt < 2; ++qt) {
            __builtin_amdgcn_sched_barrier(0);
            f32x16 p0, p1;
#pragma unroll
            for (int r = 0; r < 16; ++r) { p0[r] = 0.f; p1[r] = 0.f; }
#pragma unroll
            for (int d0 = 0; d0 < 4; ++d0) {
                const bf16x8 k0f = *(LAS const bf16x8*)(Kl + (kv * 64 + r32) * KPITCH + (16 * d0 + 8 * hi) * 2);
                const bf16x8 k1f = *(LAS const bf16x8*)(Kl + (kv * 64 + 32 + r32) * KPITCH + (16 * d0 + 8 * hi) * 2);
                const bf16x8 qf = *(LAS const bf16x8*)(Yl + (32 * qt + r32) * YPITCH + (h * 64 + d0 * 16 + hi * 8) * 2);
                p0 = __builtin_amdgcn_mfma_f32_32x32x16_bf16(k0f, qf, p0, 0, 0, 0);
                p1 = __builtin_amdgcn_mfma_f32_32x32x16_bf16(k1f, qf, p1, 0, 0, 0);
            }
            int dbase = t0 + 32 * qt + r32 - kb * 64 - 4 * hi; asm volatile("" : "+v"(dbase));
            float bm = -1e30f;
#pragma unroll
            for (int r = 0; r < 16; ++r) { const int dd = dbase - ((r & 3) + 8 * (r >> 2));
                int d_0 = dd; d_0 = d_0 < 0 ? -d_0 : d_0; int d_1 = dd - 32; d_1 = d_1 < 0 ? -d_1 : d_1;
                const float v0 = d_0 <= 128 ? p0[r] * sc2 - slope2 * (float)d_0 : -1e30f, v1 = d_1 <= 128 ? p1[r] * sc2 - slope2 * (float)d_1 : -1e30f;
                p0[r] = v0; p1[r] = v1; bm = fmaxf(bm, fmaxf(v0, v1)); }
            bm = fmaxf(bm, __shfl_xor(bm, 32));
            const float mn = fmaxf(mrun[qt], bm), alpha = fexp2(mrun[qt] - mn); mrun[qt] = mn;
            float ls = 0.f;
#pragma unroll
            for (int r = 0; r < 16; ++r) { p0[r] = fexp2(p0[r] - mn); p1[r] = fexp2(p1[r] - mn); ls += p0[r] + p1[r]; }
            lrun[qt] = lrun[qt] * alpha + ls;
#pragma unroll
            for (int dh = 0; dh < 2; ++dh)
#pragma unroll
                for (int r = 0; r < 16; ++r) o[qt][dh][r] *= alpha;
            __builtin_amdgcn_sched_barrier(0);
            bf16x8 pf[4];
            pf[0] = pack8(p0[0], p0[1], p0[2], p0[3], p0[4], p0[5], p0[6], p0[7]); pf[1] = pack8(p0[8], p0[9], p0[10], p0[11], p0[12], p0[13], p0[14], p0[15]);
            pf[2] = pack8(p1[0], p1[1], p1[2], p1[3], p1[4], p1[5], p1[6], p1[7]); pf[3] = pack8(p1[8], p1[9], p1[10], p1[11], p1[12], p1[13], p1[14], p1[15]);
#pragma unroll
            for (int ks = 0; ks < 4; ++ks)
#pragma unroll
                for (int dh = 0; dh < 2; ++dh) {
                    LAS const unsigned char* vp = Vl + (kv * 64 + 32 * dh + r32) * KPITCH + (16 * ks + 4 * hi) * 2;
                    const u32x2 a = *(LAS const u32x2*)vp, c = *(LAS const u32x2*)(vp + 16);
                    const u32x4 vv = {a.x, a.y, c.x, c.y};
                    o[qt][dh] = __builtin_amdgcn_mfma_f32_32x32x16_bf16(__builtin_bit_cast(bf16x8, vv), pf[ks], o[qt][dh], 0, 0, 0);
                }
        }
    }
#undef ATT_LOAD
    LDS_WAIT();
#pragma unroll
    for (int qt = 0; qt < 2; ++qt) { const float lt = lrun[qt] + __shfl_xor(lrun[qt], 32), inv = 1.0f / lt;
#pragma unroll
        for (int dh = 0; dh < 2; ++dh)
#pragma unroll
            for (int r4 = 0; r4 < 4; ++r4) { u32x2 w; w.x = cvt_pk_bf16(o[qt][dh][4 * r4] * inv, o[qt][dh][4 * r4 + 1] * inv); w.y = cvt_pk_bf16(o[qt][dh][4 * r4 + 2] * inv, o[qt][dh][4 * r4 + 3] * inv);
                *(LAS u32x2*)(Yl + (32 * qt + r32) * YPITCH + (h * 64 + 32 * dh + 8 * r4 + 4 * hi) * 2) = w; } }
    __syncthreads();
    rms_store(Yl, g_l, mix + (size_t)row0 * DM);
    __syncthreads();
}

struct LruP { const float *conv_w, *conv_b, *b_rg, *b_ig, *lam, *g_lru; const bf16_t* wg; };
template <int DIR> __device__ __forceinline__ void scan32(const f32x16& A, const f32x16& U, float& c, float& Atot, int hi, float (&hsv)[16]) {
    float Ag[4], Hg[4], oA[4], oH[4], cin[4];
#pragma unroll
    for (int gi = 0; gi < 4; ++gi) { const float a0 = A[4 * gi], a1 = A[4 * gi + 1], a2 = A[4 * gi + 2], a3 = A[4 * gi + 3], u0 = U[4 * gi], u1 = U[4 * gi + 1], u2 = U[4 * gi + 2], u3 = U[4 * gi + 3];
        Ag[gi] = (a0 * a1) * (a2 * a3); float hh;
        if (DIR == 0) { hh = u0; hh = a1 * hh + u1; hh = a2 * hh + u2; hh = a3 * hh + u3; } else { hh = u3; hh = a2 * hh + u2; hh = a1 * hh + u1; hh = a0 * hh + u0; }
        Hg[gi] = hh; oA[gi] = __shfl_xor(Ag[gi], 32); oH[gi] = __shfl_xor(hh, 32); }
#pragma unroll
    for (int g_ = 0; g_ < 4; ++g_) { const int gi = DIR == 0 ? g_ : 3 - g_;
        const float AE = hi ? oA[gi] : Ag[gi], HE = hi ? oH[gi] : Hg[gi], AO = hi ? Ag[gi] : oA[gi], HO = hi ? Hg[gi] : oH[gi];
        float ce, co;
        if (DIR == 0) { ce = c; c = AE * c + HE; co = c; c = AO * c + HO; } else { co = c; c = AO * c + HO; ce = c; c = AE * c + HE; }
        cin[gi] = hi ? co : ce; Atot *= AE * AO; }
#pragma unroll
    for (int gi = 0; gi < 4; ++gi) { float hh = cin[gi];
#pragma unroll
        for (int j_ = 0; j_ < 4; ++j_) { const int j = DIR == 0 ? j_ : 3 - j_; hh = A[4 * gi + j] * hh + U[4 * gi + j]; hsv[4 * gi + j] += hh; } }
}
template <bool FINAL> __device__ __forceinline__ void lru_unit(int cgi, const bf16_t* __restrict__ z, bf16_t* mix, const LruP P, f32x2* agg, LAS unsigned char* lds) {
    const int tid = opaque_tid(), lane = tid & 63, r32 = lane & 31, hi = lane >> 5, w = __builtin_amdgcn_readfirstlane(tid >> 6), c0 = 64 * w;
    const int row0 = cgi * 64, b = row_batch(row0), S = batch_len(b), seq0 = batch_row0(b), t0 = row0 - seq0, ch = t0 >> 6, nch = S >> 6, chunkbase = cgi - ch;
    LAS unsigned char* XC = lds + w * 9216; LAS unsigned char* Yl = lds + 73728;
    {
        const int cc = c0 + lane; const float cb = P.conv_b[cc], w0 = P.conv_w[cc], w1 = P.conv_w[512 + cc], w2 = P.conv_w[1024 + cc], w3 = P.conv_w[1536 + cc];
        const bf16_t* zp = z + (size_t)seq0 * DIN + 768 + cc;
#define XLD(t) (((t) >= 0 && (t) < S) ? bf2f(zp[(size_t)(t) * DIN]) : 0.f)
        float a0 = XLD(t0 - 2), a1 = XLD(t0 - 1), a2 = XLD(t0);
#pragma unroll 16
        for (int t = 0; t < 64; ++t) { const float a3 = XLD(t0 + t + 1); const float xc = cb + w0 * a0 + w1 * a1 + w2 * a2 + w3 * a3;
            *(LAS unsigned short*)(XC + t * KPITCH + lane * 2) = (unsigned short)(cvt_pk_bf16(xc, 0.f) & 0xffffu); a0 = a1; a1 = a2; a2 = a3; }
#undef XLD
        LDS_WAIT();
    }
    LAS float* CAR = (LAS float*)(lds + 140288) + w * 128;
    if (FINAL) {
        const int cc = c0 + lane; float cf = 0.f, cbk = 0.f;
        const f32x2* ap = agg + (size_t)chunkbase * 1024 + cc;
#pragma unroll 8
        for (int j = 0; j < ch; ++j) { const f32x2 ah = ap[(size_t)j * 1024]; cf = ah.x * cf + ah.y; }
#pragma unroll 8
        for (int j = nch - 1; j > ch; --j) { const f32x2 ah = ap[(size_t)j * 1024 + 512]; cbk = ah.x * cbk + ah.y; }
        CAR[lane] = cf; CAR[64 + lane] = cbk;
        LDS_WAIT();
    }
#pragma unroll 1
    for (int mt = 0; mt < 2; ++mt) {
        const int chn = c0 + 32 * mt + r32;
        float hs[2][16];
#pragma unroll
        for (int s = 0; s < 2; ++s)
#pragma unroll
            for (int r = 0; r < 16; ++r) hs[s][r] = 0.f;
#pragma unroll
        for (int dir = 0; dir < 2; ++dir) {
            __builtin_amdgcn_sched_barrier(0);
            const float brg = P.b_rg[dir * 512 + chn], big = P.b_ig[dir * 512 + chn];
            const float lamv = P.lam[dir * 512 + chn], clam = -8.0f * log1pf(expf(-lamv)) * LOG2E;
            float c = 0.f, Atot = 1.f;
            if (FINAL) c = CAR[dir * 64 + 32 * mt + r32];
            const bf16_t* wr_ = P.wg + ((size_t)((dir * 2 + 0) * 8 + w) * 64 + 32 * mt + r32) * 64 + hi * 8;
            const bf16_t* wi_ = P.wg + ((size_t)((dir * 2 + 1) * 8 + w) * 64 + 32 * mt + r32) * 64 + hi * 8;
            bf16x8 bfr[4], bfi[4];
#pragma unroll
            for (int ks = 0; ks < 4; ++ks) { bfr[ks] = *(const bf16x8*)(wr_ + ks * 16); bfi[ks] = *(const bf16x8*)(wi_ + ks * 16); }
#pragma unroll
            for (int si = 0; si < 2; ++si) { const int s = dir ? 1 - si : si;
                __builtin_amdgcn_sched_barrier(0);
                f32x16 accr, acci;
#pragma unroll
                for (int r = 0; r < 16; ++r) { accr[r] = 0.f; acci[r] = 0.f; }
#pragma unroll
                for (int ks = 0; ks < 4; ++ks) { const bf16x8 af = *(LAS const bf16x8*)(XC + (32 * s + r32) * KPITCH + (16 * ks + 8 * hi) * 2);
                    accr = __builtin_amdgcn_mfma_f32_32x32x16_bf16(af, bfr[ks], accr, 0, 0, 0); acci = __builtin_amdgcn_mfma_f32_32x32x16_bf16(af, bfi[ks], acci, 0, 0, 0); }
#pragma unroll
                for (int r = 0; r < 16; ++r) { const float xv = bf2f(*(LAS const unsigned short*)(XC + (32 * s + crow(r, hi)) * KPITCH + (32 * mt + r32) * 2));
                    const float rr = fsigmoid(accr[r] + brg), ii = fsigmoid(acci[r] + big), a = fexp2(rr * clam);
                    accr[r] = a; acci[r] = __builtin_amdgcn_sqrtf(fmaxf(1.0f - a * a, 0.f)) * ii * xv; }
                if (dir == 0) scan32<0>(accr, acci, c, Atot, hi, hs[s]); else scan32<1>(accr, acci, c, Atot, hi, hs[s]);
            }
            if (!FINAL) { if (hi == 0) agg[((size_t)cgi * 2 + dir) * 512 + chn] = (f32x2){Atot, c}; }
        }
        if (FINAL) {
#pragma unroll
            for (int s = 0; s < 2; ++s) { __builtin_amdgcn_sched_barrier(0);
#pragma unroll
                for (int r = 0; r < 16; ++r) { const int t = 32 * s + crow(r, hi); const float gte = bf2f(z[(size_t)(row0 + t) * DIN + 1280 + chn]);
                    const float ge = gte * frcp(1.0f + fexp2(-LOG2E * 1.5957691216f * (gte + 0.044715f * gte * gte * gte)));
                    *(LAS unsigned short*)(Yl + t * YPITCH + chn * 2) = (unsigned short)(cvt_pk_bf16(hs[s][r] * ge, 0.f) & 0xffffu); } }
        }
    }
    if (FINAL) {
        __syncthreads();
        rms_store(Yl, P.g_lru, mix + (size_t)row0 * DM + 512);
        __syncthreads();
    }
}

#ifndef EN_P0
#define EN_P0 1
#endif
#ifndef EN_P1
#define EN_P1 1
#endif
#ifndef EN_G1
#define EN_G1 1
#endif
#ifndef EN_G2
#define EN_G2 1
#endif
#ifndef EN_G3
#define EN_G3 1
#endif
#ifndef EN_G4
#define EN_G4 1
#endif
#ifndef EN_ATT
#define EN_ATT 1
#endif
#ifndef EN_LRUA
#define EN_LRUA 1
#endif
#ifndef EN_LRUB
#define EN_LRUB 1
#endif
#ifndef REP_P0
#define REP_P0 1
#endif
#ifndef REP_P1
#define REP_P1 1
#endif
#ifndef REP_G1
#define REP_G1 1
#endif
#ifndef REP_G3
#define REP_G3 1
#endif
#ifndef REP_ATT
#define REP_ATT 1
#endif
#ifndef REP_LRUA
#define REP_LRUA 1
#endif
#ifndef REP_LRUB
#define REP_LRUB 1
#endif
__global__ void __launch_bounds__(512, 2) fwd_megakernel(Args a) {
    extern __shared__ __attribute__((aligned(16))) unsigned char lds_raw[];
    LAS unsigned char* lds = (LAS unsigned char*)lds_raw;
    cg::grid_group grid = cg::this_grid();
    const int G = gridDim.x, bx = blockIdx.x, NGW = G * 8;
#define PHASE_IDS() const int tid = opaque_tid(), lane = tid & 63, wave = __builtin_amdgcn_readfirstlane(tid >> 6), gw = bx * 8 + wave; (void)lane; (void)gw
    unsigned char* ws = a.ws;
    bf16_t* Wt_in = (bf16_t*)(ws + WS_WIN); bf16_t* Wt_out = (bf16_t*)(ws + WS_WOUT); bf16_t* Wt_fi = (bf16_t*)(ws + WS_WFI); bf16_t* Wt_fo = (bf16_t*)(ws + WS_WFO);
    bf16_t* Wg = (bf16_t*)(ws + WS_WG); float* mod = (float*)(ws + WS_MOD); float* shw1 = (float*)(ws + WS_SHW1); float* shw2 = (float*)(ws + WS_SHW2);
    float* rsq1 = (float*)(ws + WS_RSQ1); float* rsq2 = (float*)(ws + WS_RSQ2); f32x2* agg = (f32x2*)(ws + WS_AGG);
    bf16_t* hb = (bf16_t*)(ws + WS_HB); bf16_t* zb = (bf16_t*)(ws + WS_Z); bf16_t* mix = (bf16_t*)(ws + WS_MIX); bf16_t* hid = (bf16_t*)(ws + WS_HID);
    float* xres = a.out;

    for (int rep_ = 0; rep_ < REP_P0; ++rep_) {
        PHASE_IDS();
        LAS float* vl = (LAS float*)lds; LAS float* red = (LAS float*)(lds + 81920);
        if (bx < 384) {
            for (int i = tid; i < NB * 1024; i += 512) { const int b = i >> 10, k = i & 1023; const float v = b < 4 ? a.in[2][b * 1024 + k] : a.in[3][(b - 4) * 1024 + k];
                vl[k * NB + b] = v * fsigmoid(v); }
            __syncthreads();
            for (int it = bx; it < 384; it += G) { const int l = it / 96, chk = it % 96;
                gemv20_item(a.in[4] + (size_t)l * DM * NMODC, NMODC, chk * 64, vl, red, mod + (size_t)l * NB * NMODC, NMODC, chk * 64, a.in[5] + (size_t)l * NMODC); }
        }
        __syncthreads();
        LAS float* scr = (LAS float*)(lds + wave * 8448);
        constexpr int I_IN = 16 * 56, I_OUT = 16 * 32, I_FI = 16 * 176, I_FO = 44 * 32, I_L = I_IN + I_OUT + I_FI + I_FO;
        for (int it = gw; it < NLAYER * I_L; it += NGW) { const int l = it / I_L; int r = it % I_L;
            if (r < I_IN) { transpose_item<0>(a.in[7] + (size_t)l * DM * DIN, DM, DIN, Wt_in + (size_t)l * DIN * DM, scr, r, lane); continue; } r -= I_IN;
            if (r < I_OUT) { transpose_item<0>(a.in[18] + (size_t)l * DM * DM, DM, DM, Wt_out + (size_t)l * DM * DM, scr, r, lane); continue; } r -= I_OUT;
            if (r < I_FI) { transpose_item<1>(a.in[20] + (size_t)l * DM * NFI, DM, NFI, Wt_fi + (size_t)l * NFI * DM, scr, r, lane); continue; } r -= I_FI;
            transpose_item<0>(a.in[21] + (size_t)l * DFF * DM, DFF, DM, Wt_fo + (size_t)l * DM * DFF, scr, r, lane); }
        for (int i = bx * 512 + tid; i < NLAYER * 2 * 2 * 8 * 64 * 64; i += G * 512) { const int c = i & 63, m = (i >> 6) & 63, blk = (i >> 12) & 7, gate = (i >> 15) & 1, dir = (i >> 16) & 1, l = i >> 17;
            const float* src = gate ? a.in[13] : a.in[11]; const float v = src[((size_t)((l * 2 + dir) * 8 + blk) * 64 + c) * 64 + m];
            Wg[i] = (bf16_t)(cvt_pk_bf16(v, 0.f) & 0xffffu); }
    }
    grid.sync();
    for (int rep_ = 0; rep_ < REP_P1; ++rep_) {
        PHASE_IDS();
        LAS float* vl = (LAS float*)lds; LAS float* red = (LAS float*)(lds + 81920);
        for (int it = bx; it < NLAYER * 116; it += G) { const int l = it / 116, r = it % 116, which = r >= 28 ? 1 : 0, chk = which ? r - 28 : r;
            const float* src = mod + (size_t)l * NB * NMODC + (which ? 3072 : 0);
            for (int i = tid; i < NB * 1024; i += 512) { const int b = i >> 10, k = i & 1023; vl[k * NB + b] = src[(size_t)b * NMODC + k]; }
            __syncthreads();
            if (!which) gemv20_item(a.in[7] + (size_t)l * DM * DIN, DIN, chk * 64, vl, red, shw1 + (size_t)l * NB * DIN, DIN, chk * 64, nullptr);
            else { const int n0 = chk * 64, sc_ = ((n0 >> 7) & 1) * DFF + (n0 >> 8) * 128 + (n0 & 127);
                gemv20_item(a.in[20] + (size_t)l * DM * NFI, NFI, sc_, vl, red, shw2 + (size_t)l * NB * NFI, NFI, n0, nullptr); }
        }
        for (int row = gw; row < MTOK; row += NGW) {
            const float* xr = row < 16384 ? a.in[0] + (size_t)row * DM : a.in[1] + (size_t)(row - 16384) * DM; const int b = row_batch(row);
            f32x4 v[4]; float ss = 0.f;
#pragma unroll
            for (int j = 0; j < 4; ++j) { v[j] = ((const f32x4*)xr)[64 * j + lane]; ss += (v[j][0] * v[j][0] + v[j][1] * v[j][1]) + (v[j][2] * v[j][2] + v[j][3] * v[j][3]); }
            ss = wave_sum(ss);
#pragma unroll
            for (int j = 0; j < 4; ++j) { const int col = (64 * j + lane) * 4; ((f32x4*)(xres + (size_t)row * DM))[64 * j + lane] = v[j];
                const f32x4 g4 = *(const f32x4*)(a.in[6] + col), s4 = *(const f32x4*)(mod + (size_t)b * NMODC + 1024 + col); const f32x4 hv = v[j] * g4 * (s4 + 1.0f);
                u32x2 w2; w2.x = cvt_pk_bf16(hv[0], hv[1]); w2.y = cvt_pk_bf16(hv[2], hv[3]); *(u32x2*)(hb + (size_t)row * DM + col) = w2; }
            if (lane < 16) rsq1[(size_t)lane * MTOK + row] = lane == 0 ? ss : 0.f;
        }
    }
    grid.sync();
#pragma unroll 1
    for (int l = 0; l < NLAYER; ++l) {
        const float* modl = mod + (size_t)l * NB * NMODC;
        for (int rep_ = 0; rep_ < REP_G1; ++rep_) {
            pg8::Gemm g{hb, Wt_in + (size_t)l * DIN * DM, MTOK, DIN, DM}; pg8::StaticOrder S; S.init(MTOK, DIN, G, bx);
            pg8::EpiZ E{zb, DIN, rsq1, shw1 + (size_t)l * NB * DIN};
            pg8::gemm_phase<pg8::EpiZ, pg8::StaticOrder, true, true>(lds, g, S, E);
        }
        grid.sync();
        if (EN_ATT || EN_LRUA) {
            LruP P{a.in[9] + (size_t)l * 4 * 512, a.in[10] + (size_t)l * 512, a.in[12] + (size_t)l * 1024, a.in[14] + (size_t)l * 1024, a.in[15] + (size_t)l * 1024, a.in[17] + (size_t)l * 512, Wg + (size_t)l * 2 * 2 * 8 * 64 * 64};
            for (int u = bx; u < 1536; u += G) { if (u < 768) { for (int rep_ = 0; rep_ < REP_ATT; ++rep_) attn_unit(u, zb, mix, a.in[8] + l * 8, a.in[16] + (size_t)l * 512, lds); } else { for (int rep_ = 0; rep_ < REP_LRUA; ++rep_) lru_unit<false>(u - 768, zb, mix, P, agg, lds); } }
        }
        grid.sync();
        for (int rep_ = 0; rep_ < REP_LRUB; ++rep_) {
            LruP P{a.in[9] + (size_t)l * 4 * 512, a.in[10] + (size_t)l * 512, a.in[12] + (size_t)l * 1024, a.in[14] + (size_t)l * 1024, a.in[15] + (size_t)l * 1024, a.in[17] + (size_t)l * 512, Wg + (size_t)l * 2 * 2 * 8 * 64 * 64};
            for (int u = bx; u < 768; u += G) lru_unit<true>(u, zb, mix, P, agg, lds);
        }
        grid.sync();
        if (EN_G2) {
            pg8::Gemm g{mix, Wt_out + (size_t)l * DM * DM, MTOK, DM, DM}; pg8::StaticOrder S; S.init(MTOK, DM, G, bx);
            pg8::EpiRes E{xres, modl + 2048, a.in[19] + (size_t)l * DM, modl + 4096, hb, rsq2};
            pg8::gemm_phase<pg8::EpiRes, pg8::StaticOrder, true, true>(lds, g, S, E);
        }
        grid.sync();
        for (int rep_ = 0; rep_ < REP_G3; ++rep_) {
            pg8::Gemm g{hb, Wt_fi + (size_t)l * NFI * DM, MTOK, NFI, DM}; pg8::StaticOrder S; S.init(MTOK, NFI, G, bx);
            pg8::EpiSwiGLU E{hid, rsq2, shw2 + (size_t)l * NB * NFI};
            pg8::gemm_phase<pg8::EpiSwiGLU, pg8::StaticOrder, true, true>(lds, g, S, E);
        }
        grid.sync();
        if (EN_G4) {
            const bool last = (l == NLAYER - 1);
            pg8::Gemm g{hid, Wt_fo + (size_t)l * DM * DFF, MTOK, DM, DFF}; pg8::StaticOrder S; S.init(MTOK, DM, G, bx);
            pg8::EpiRes E{xres, modl + 5120, last ? a.in[6] : a.in[6] + (size_t)(l + 1) * DM, last ? modl + 1024 : modl + (size_t)NB * NMODC + 1024, last ? (bf16_t*)nullptr : hb, rsq1};
            pg8::gemm_phase<pg8::EpiRes, pg8::StaticOrder, true, true>(lds, g, S, E);
        }
        grid.sync();
    }
    PHASE_IDS();
    for (int row = gw; row < MTOK; row += NGW) {
        float s = lane < 16 ? rsq1[(size_t)lane * MTOK + row] : 0.f; s = wave_sum(s);
        const float rs = rsqrtf(s * (1.0f / DM) + EPS);
        f32x4* xr = (f32x4*)(xres + (size_t)row * DM);
#pragma unroll
        for (int j = 0; j < 4; ++j) { const f32x4 v = xr[64 * j + lane], g4 = ((const f32x4*)a.in[22])[64 * j + lane]; xr[64 * j + lane] = v * rs * g4; }
    }
}

extern "C" void kernel_launch(void* const* d_in, const int* in_sizes, int n_in, void* d_out, int out_size, void* d_ws, size_t ws_size, hipStream_t stream) {
    static int grid = 0;
    if (grid == 0) {
        int dev = 0, cus = 0, per_cu = 0;
        (void)hipGetDevice(&dev);
        (void)hipDeviceGetAttribute(&cus, hipDeviceAttributeMultiprocessorCount, dev);
        (void)hipFuncSetAttribute((const void*)fwd_megakernel, hipFuncAttributeMaxDynamicSharedMemorySize, LDS_BYTES);
        (void)hipOccupancyMaxActiveBlocksPerMultiprocessor(&per_cu, (const void*)fwd_megakernel, 512, LDS_BYTES);
        (void)hipGetLastError();
        grid = cus > 0 ? cus : 256;
        if (n_in != 23 || ws_size < WS_END) { fprintf(stderr, "kernel_launch: unexpected n_in %d / ws %zu\n", n_in, ws_size); }
    }
    Args a{};
    for (int i = 0; i < 23; ++i) a.in[i] = (const float*)d_in[i];
    a.out = (float*)d_out; a.ws = (unsigned char*)d_ws;
    void* args[] = {&a};
    hipError_t e = hipLaunchCooperativeKernel((const void*)fwd_megakernel, dim3(grid), dim3(512), args, LDS_BYTES, stream);
    if (e != hipSuccess) fprintf(stderr, "cooperative launch failed: %s (grid %d)\n", hipGetErrorString(e), grid);
}
```

```cpp
#include <hip/hip_runtime.h>
#include <hip/hip_cooperative_groups.h>
#include <cstdio>
#include <cstdint>
namespace cg = cooperative_groups;

constexpr int MTOK = 49152, DM = 1024, DIN = 1792, DFF = 2816, NFI = 5632, NLAYER = 4, NB = 20, NMODC = 6144;
constexpr float EPS = 1e-6f, LOG2E = 1.4426950408889634f;
__device__ __forceinline__ int row_batch(int row) { return row < 16384 ? (row >> 12) : 4 + ((row - 16384) >> 11); }
__device__ __forceinline__ int batch_row0(int b) { return b < 4 ? b * 4096 : 16384 + (b - 4) * 2048; }
__device__ __forceinline__ int batch_len(int b) { return b < 4 ? 4096 : 2048; }
namespace pg8 {
#define PG8_LAS __attribute__((address_space(3)))
typedef unsigned short bf16_t;
typedef short bf16x8 __attribute__((ext_vector_type(8)));
typedef float f32x4 __attribute__((ext_vector_type(4)));
typedef unsigned u32x4 __attribute__((ext_vector_type(4)));
constexpr int BM = 256, BK = 64, HALF = 128, HTB = HALF * BK * 2  , STAGE_BYTES = 8 * HTB, NXCD = 8, WGM = 8;

__host__ __device__ __forceinline__ int lds_byte(int r, int c) { const int st = (r >> 4) * 2 + (c >> 5), rr = r & 15, cc = c & 31, ob = rr * 64 + cc * 2; return st * 1024 + (ob ^ (((ob >> 9) & 1) << 5)); }
__host__ __device__ __forceinline__ void stage_rc(int b, int& R, int& C) { const int st = b / 1024, sb = b % 1024, swz = sb ^ (((sb >> 9) & 1) << 5); R = (st >> 1) * 16 + swz / 64; C = (st & 1) * 32 + (swz % 64) / 2; }
__host__ __device__ __forceinline__ int perm32(int rho) { const int n = rho >> 4, i = rho & 15; return 8 * (i >> 2) + 4 * n + (i & 3); }

struct Unit { int pm, pn; };
struct Gemm { const bf16_t* A; const bf16_t* Bt; int M, N, K; };

struct StaticOrder {
    int nM, nN, nwg, G, c;
    __host__ __device__ void init(int M, int N, int G_, int c_) { nM = M / BM; nN = N / BM; nwg = nM * nN; G = G_; c = c_; }
    __host__ __device__ bool next(int i, Unit& u) const {
        const long L = (long)i * G + c; if (L >= nwg) return false;
        int wgid = (int)L; { const int q = nwg / NXCD, r = nwg % NXCD, xcd = wgid % NXCD, off = wgid / NXCD; wgid = (xcd < r ? xcd * (q + 1) : r * (q + 1) + (xcd - r) * q) + off; }
        const int nig = WGM * nN, gid = wgid / nig, fm = gid * WGM, gsz = (nM - fm) < WGM ? (nM - fm) : WGM;
        u.pm = fm + ((wgid % nig) % gsz); u.pn = (wgid % nig) / gsz; return true;
    }
    __device__ __forceinline__ void a_ready(const Unit&) const {}
    __device__ __forceinline__ void done(const Unit&) const {}
};

__device__ __forceinline__ unsigned cvt_pk_bf16(float lo, float hi) { unsigned r; asm("v_cvt_pk_bf16_f32 %0, %1, %2" : "=v"(r) : "v"(lo), "v"(hi)); return r; }
__device__ __forceinline__ void rows_rstd(const float* rowsq, int row0, int fq, float (&rs)[8]) {
    float part[8][4];
#pragma unroll
    for (int g = 0; g < 8; ++g)
#pragma unroll
        for (int p = 0; p < 4; ++p) part[g][p] = rowsq[(size_t)(fq * 4 + p) * MTOK + row0 + (g >> 2) * HALF + (g & 3) * 16];
    asm volatile("" ::: "memory");
#pragma unroll
    for (int g = 0; g < 8; ++g) { float s = (part[g][0] + part[g][1]) + (part[g][2] + part[g][3]); s += __shfl_xor(s, 16); s += __shfl_xor(s, 32); rs[g] = rsqrtf(s * (1.0f / DM) + EPS); }
}
__device__ __forceinline__ void epi_prefetch(const float* rowsq, const float* biasrow, const Unit& u, PG8_LAS unsigned char* lds, int wid, int lane) {
    const float* g0 = rowsq + (size_t)(lane & 15) * MTOK + u.pm * BM + wid * 32 + (lane >> 4);
#pragma unroll
    for (int i = 0; i < 8; ++i)
        __builtin_amdgcn_global_load_lds((const unsigned*)(g0 + i * 4), (PG8_LAS unsigned*)(lds + 131072 + (wid * 32 + i * 4) * 64), 4, 0, 0);
    __builtin_amdgcn_global_load_lds((const unsigned*)(biasrow + u.pn * BM + (wid & 3) * 64 + lane), (PG8_LAS unsigned*)(lds + 147456 + wid * 256), 4, 0, 0);
}
__device__ __forceinline__ void rows_rstd_lds(PG8_LAS unsigned char* lds, int wr, int fr, int fq, float (&rs)[8]) {
#pragma unroll
    for (int g = 0; g < 8; ++g) { const f32x4 pv = *(const PG8_LAS f32x4*)(lds + 131072 + ((g >> 2) * HALF + wr * 64 + (g & 3) * 16 + fr) * 64 + fq * 16);
        float s = (pv[0] + pv[1]) + (pv[2] + pv[3]); s += __shfl_xor(s, 16); s += __shfl_xor(s, 32); rs[g] = rsqrtf(s * (1.0f / DM) + EPS); }
}
struct EpiZ {
    static constexpr bool PERM = true, AFTER_DRAIN = false;
    static constexpr int NPREF = 0;
    bf16_t* O; int ldc; const float* rowsq; const float* shw; PG8_LAS unsigned char* lds;
    __device__ __forceinline__ void prefetch(const Unit& u, PG8_LAS unsigned char* l_, int wid, int lane) const { epi_prefetch(rowsq, shw + (size_t)row_batch(u.pm * BM) * ldc, u, l_, wid, lane); }
    __device__ __forceinline__ void operator()(const f32x4 (&acc)[2][2][4][2], const Unit& u, int wr, int wc, int fr, int fq) const {
        const int row0 = u.pm * BM + wr * 64 + fr; const int b = row_batch(u.pm * BM);
        const int col0 = u.pn * BM + wc * 32 + 8 * fq;
        f32x4 bv[2][2];
#pragma unroll
        for (int bj = 0; bj < 2; ++bj)
#pragma unroll
            for (int n = 0; n < 2; ++n) bv[bj][n] = *(const f32x4*)(shw + (size_t)b * ldc + col0 + bj * HALF + 4 * n);
        float rsv[8]; rows_rstd(rowsq, row0, fq, rsv);
#pragma unroll
        for (int ai = 0; ai < 2; ++ai)
#pragma unroll
            for (int m = 0; m < 4; ++m) { const int row = row0 + ai * HALF + m * 16; const float rs = rsv[ai * 4 + m];
                bf16_t* rowp = O + (size_t)row * ldc + col0;
#pragma unroll
                for (int bj = 0; bj < 2; ++bj) { const f32x4 v0 = acc[ai][bj][m][0] * rs + bv[bj][0], v1 = acc[ai][bj][m][1] * rs + bv[bj][1];
                    u32x4 w; w.x = cvt_pk_bf16(v0[0], v0[1]); w.y = cvt_pk_bf16(v0[2], v0[3]); w.z = cvt_pk_bf16(v1[0], v1[1]); w.w = cvt_pk_bf16(v1[2], v1[3]);
                    *(u32x4*)(rowp + bj * HALF) = w; } }
    }
};
struct EpiSwiGLU {
    static constexpr bool PERM = true, AFTER_DRAIN = false;
    static constexpr int NPREF = 0;
    bf16_t* O; const float* rowsq; const float* shw; PG8_LAS unsigned char* lds;
    __device__ __forceinline__ void prefetch(const Unit& u, PG8_LAS unsigned char* l_, int wid, int lane) const { epi_prefetch(rowsq, shw + (size_t)row_batch(u.pm * BM) * NFI, u, l_, wid, lane); }
    __device__ __forceinline__ void operator()(const f32x4 (&acc)[2][2][4][2], const Unit& u, int wr, int wc, int fr, int fq) const {
        const int row0 = u.pm * BM + wr * 64 + fr; const int b = row_batch(u.pm * BM);
        const int col0 = u.pn * BM + wc * 32 + 8 * fq, ocol = u.pn * HALF + wc * 32 + 8 * fq;
        f32x4 bv[2][2];
#pragma unroll
        for (int bj = 0; bj < 2; ++bj)
#pragma unroll
            for (int n = 0; n < 2; ++n) bv[bj][n] = *(const f32x4*)(shw + (size_t)b * NFI + col0 + bj * HALF + 4 * n);
        float rsv[8]; rows_rstd(rowsq, row0, fq, rsv);
#pragma unroll
        for (int ai = 0; ai < 2; ++ai)
#pragma unroll
            for (int m = 0; m < 4; ++m) { const int row = row0 + ai * HALF + m * 16; const float rs = rsv[ai * 4 + m];
                float o[8];
#pragma unroll
                for (int n = 0; n < 2; ++n) { const f32x4 g = acc[ai][0][m][n] * rs + bv[0][n], uu = acc[ai][1][m][n] * rs + bv[1][n];
#pragma unroll
                    for (int j = 0; j < 4; ++j) { const float s = __builtin_amdgcn_rcpf(1.0f + __builtin_amdgcn_exp2f(-LOG2E * g[j])); o[4 * n + j] = g[j] * s * uu[j]; } }
                u32x4 w; w.x = cvt_pk_bf16(o[0], o[1]); w.y = cvt_pk_bf16(o[2], o[3]); w.z = cvt_pk_bf16(o[4], o[5]); w.w = cvt_pk_bf16(o[6], o[7]);
                *(u32x4*)(O + (size_t)row * DFF + ocol) = w; }
    }
};
struct EpiRes {
    static constexpr bool PERM = true, AFTER_DRAIN = false;
    static constexpr int NPREF = 0;
    __device__ __forceinline__ void prefetch(const Unit&, PG8_LAS unsigned char*, int, int) const {}
    unsigned short* x; const float* gt; const float* gn; const float* sc; bf16_t* hb; float* rowsq_out; float gsc;
    __device__ __forceinline__ void operator()(const f32x4 (&acc)[2][2][4][2], const Unit& u, int wr, int wc, int fr, int fq) const {
        const int row0 = u.pm * BM + wr * 64 + fr; const int b = row_batch(u.pm * BM);
        const int col0 = u.pn * BM + wc * 32 + 8 * fq;
        f32x4 (&A)[2][2][4][2] = const_cast<f32x4 (&)[2][2][4][2]>(acc);
        typedef _Float16 f16x8 __attribute__((ext_vector_type(8))); typedef float f32x8 __attribute__((ext_vector_type(8)));
        u32x4 xv[3][2]; float ssv[8];
        const unsigned idx0 = (unsigned)row0 * DM + col0;
#define EPR_LOADX(buf, st_) do { const int bj_ = (st_) >> 2, ai_ = ((st_) & 3) >> 1, m0_ = ((st_) & 1) * 2; unsigned ib_ = idx0 + (ai_ * HALF + m0_ * 16) * DM + bj_ * HALF; asm volatile("" : "+v"(ib_)); \
        _Pragma("unroll") for (int mm = 0; mm < 2; ++mm) xv[buf][mm] = *(const u32x4*)(x + (ib_ + mm * 16 * DM)); } while (0)
        EPR_LOADX(0, 0); EPR_LOADX(1, 1);
#pragma unroll
        for (int g = 0; g < 8; ++g) ssv[g] = 0.f;
#pragma unroll
        for (int bj = 0; bj < 2; ++bj)
#pragma unroll
            for (int n = 0; n < 2; ++n) { const f32x4 gv = *(const f32x4*)(gt + (size_t)b * NMODC + col0 + bj * HALF + 4 * n) * gsc;
#pragma unroll
                for (int ai = 0; ai < 2; ++ai)
#pragma unroll
                    for (int m = 0; m < 4; ++m) A[ai][bj][m][n] *= gv; }
        f32x4 mvb[2];
#pragma unroll
        for (int st = 0; st < 8; ++st) { const int bj = st >> 2, ai = (st & 3) >> 1, m0 = (st & 1) * 2, cur = st % 3;
            if ((st & 3) == 0) {
#pragma unroll
                for (int n = 0; n < 2; ++n) { const int c = col0 + bj * HALF + 4 * n;
                    if (hb) { const f32x4 g4 = *(const f32x4*)(gn + c), s4 = *(const f32x4*)(sc + (size_t)b * NMODC + c); mvb[n] = g4 * (s4 + 1.0f); } else mvb[n] = (f32x4){0.f, 0.f, 0.f, 0.f}; }
            }
            if (st + 2 < 8) EPR_LOADX((st + 2) % 3, st + 2);
            asm volatile("" ::: "memory");
            unsigned ib = idx0 + (ai * HALF + m0 * 16) * DM + bj * HALF; asm volatile("" : "+v"(ib));
#pragma unroll
            for (int mm = 0; mm < 2; ++mm) { const int m = m0 + mm; f32x4 xn[2]; float ss = 0.f;
                const f32x8 xf = __builtin_convertvector(__builtin_bit_cast(f16x8, xv[cur][mm]), f32x8);
                xn[0] = (f32x4){xf[0], xf[1], xf[2], xf[3]} + A[ai][bj][m][0]; xn[1] = (f32x4){xf[4], xf[5], xf[6], xf[7]} + A[ai][bj][m][1];
#pragma unroll
                for (int n = 0; n < 2; ++n) ss += (xn[n][0] * xn[n][0] + xn[n][1] * xn[n][1]) + (xn[n][2] * xn[n][2] + xn[n][3] * xn[n][3]);
                { const f32x8 o8 = {xn[0][0], xn[0][1], xn[0][2], xn[0][3], xn[1][0], xn[1][1], xn[1][2], xn[1][3]};
                  *(u32x4*)(x + (ib + mm * 16 * DM)) = __builtin_bit_cast(u32x4, __builtin_convertvector(o8, f16x8)); }
                ssv[ai * 4 + m] += ss;
                if (hb) { const f32x4 h0 = xn[0] * mvb[0], h1 = xn[1] * mvb[1];
                    u32x4 w; w.x = cvt_pk_bf16(h0[0], h0[1]); w.y = cvt_pk_bf16(h0[2], h0[3]); w.z = cvt_pk_bf16(h1[0], h1[1]); w.w = cvt_pk_bf16(h1[2], h1[3]);
                    *(u32x4*)(hb + (ib + mm * 16 * DM)) = w; } }
        }
#undef EPR_LOADX
#pragma unroll
        for (int g = 0; g < 8; ++g) { float ss = ssv[g]; ss += __shfl_xor(ss, 16); ss += __shfl_xor(ss, 32);
            if (fq == 0) rowsq_out[(size_t)(u.pn * 4 + wc) * MTOK + row0 + (g >> 2) * HALF + (g & 3) * 16] = ss; }
    }
};

template <class Epi, class Sched, bool ALIGN_EPI = false, bool SP2 = false>
__device__ __forceinline__ void gemm_phase(PG8_LAS unsigned char* lds, const Gemm g, const Sched& S, const Epi& E) {
    int tid_ = threadIdx.x; asm volatile("" : "+v"(tid_)); const int tid = tid_, wid = __builtin_amdgcn_readfirstlane(tid >> 6), lane = tid & 63, wr = wid >> 2, wc = wid & 3, fr = lane & 15, fq = lane >> 4;
    const int K = g.K, nt = K / BK;
    unsigned voffA[2], voffB[2];
#pragma unroll
    for (int i = 0; i < 2; ++i) { int R, C; stage_rc(tid * 16 + i * 8192, R, C); const int Rb = Epi::PERM ? ((R & ~31) + perm32(R & 31)) : R;
        voffA[i] = (unsigned)(R * K + C) * 2u; voffB[i] = (unsigned)(Rb * K + C) * 2u; }
    const size_t kstep = (size_t)(BK * 2);
    const size_t hstep = (size_t)HALF * K * 2;
    const size_t tstep = 2 * hstep;
    const unsigned ldsw = (unsigned)wid * 1024u;
    const int aoff = lds_byte(wr * 64 + fr, fq * 8), boff = lds_byte(wc * 32 + fr, fq * 8);
#define PG8_SA(b, h) (((b) * 2 + (h)) * HTB)
#define PG8_SB(b, h) ((4 + (b) * 2 + (h)) * HTB)
#define PG8_STAGE(bufoff, gbase, voff) do { _Pragma("unroll") for (int _i = 0; _i < 2; ++_i) \
        __builtin_amdgcn_global_load_lds((const unsigned*)((const char*)(gbase) + (voff)[_i]), (PG8_LAS unsigned*)(lds + (bufoff) + ldsw + _i * 8192), 16, 0, 0); } while (0)
#define PG8_LDA(dst, b, h) do { _Pragma("unroll") for (int m = 0; m < 4; ++m) _Pragma("unroll") for (int k = 0; k < 2; ++k) dst[m][k] = *(const PG8_LAS bf16x8*)(lds + PG8_SA(b, h) + aoff + m * 2048 + k * 1024); } while (0)
#define PG8_LDB(dst, b, h) do { _Pragma("unroll") for (int n = 0; n < 2; ++n) _Pragma("unroll") for (int k = 0; k < 2; ++k) dst[n][k] = *(const PG8_LAS bf16x8*)(lds + PG8_SB(b, h) + boff + n * 2048 + k * 1024); } while (0)
#define PG8_MMA(ai, bj, At, Bt) do { __builtin_amdgcn_s_setprio(1); _Pragma("unroll") for (int m = 0; m < 4; ++m) _Pragma("unroll") for (int n = 0; n < 2; ++n) _Pragma("unroll") for (int k = 0; k < 2; ++k) \
        acc[ai][bj][m][n] = __builtin_amdgcn_mfma_f32_16x16x32_bf16(Bt[n][k], At[m][k], acc[ai][bj][m][n], 0, 0, 0); __builtin_amdgcn_s_setprio(0); } while (0)
#define PG8_WAIT_V(n) asm volatile("s_waitcnt vmcnt(" #n ")" ::: "memory")
#define PG8_WAIT_L(n) asm volatile("s_waitcnt lgkmcnt(" #n ")" ::: "memory")
#define PG8_BAR __builtin_amdgcn_s_barrier()
#define PG8_SCHED __builtin_amdgcn_sched_barrier(0)
    Unit cur, nxt; int ui = 0;
    if (!S.next(0, cur)) return;
    f32x4 acc[2][2][4][2];
#pragma unroll
    for (int a = 0; a < 2; ++a)
#pragma unroll
        for (int b = 0; b < 2; ++b)
#pragma unroll
            for (int m = 0; m < 4; ++m)
#pragma unroll
                for (int n = 0; n < 2; ++n) acc[a][b][m][n] = (f32x4){0.f, 0.f, 0.f, 0.f};
    bf16x8 At[4][2], B0[2][2], B1[2][2];
    const char* cA = (const char*)g.A + (size_t)cur.pm * tstep; const char* cB = (const char*)g.Bt + (size_t)cur.pn * tstep;
    S.a_ready(cur);
    if constexpr (SP2) {
        PG8_STAGE(PG8_SB(0, 0), cB, voffB); PG8_STAGE(PG8_SB(0, 1), cB + hstep, voffB); PG8_STAGE(PG8_SA(0, 0), cA, voffA); PG8_STAGE(PG8_SA(0, 1), cA + hstep, voffA);
        if (wr == 1) PG8_BAR;
        PG8_WAIT_V(2); PG8_BAR;
        PG8_STAGE(PG8_SB(1, 0), cB + kstep, voffB); PG8_STAGE(PG8_SA(1, 0), cA + kstep, voffA); PG8_STAGE(PG8_SB(1, 1), cB + hstep + kstep, voffB);
        PG8_WAIT_V(6); PG8_BAR;
    } else {
        PG8_STAGE(PG8_SB(0, 0), cB, voffB); PG8_STAGE(PG8_SA(0, 0), cA, voffA); PG8_STAGE(PG8_SB(0, 1), cB + hstep, voffB); PG8_STAGE(PG8_SA(0, 1), cA + hstep, voffA);
        if (wr == 1) PG8_BAR;
        PG8_WAIT_V(4); PG8_BAR;
        PG8_STAGE(PG8_SB(1, 0), cB + kstep, voffB); PG8_STAGE(PG8_SA(1, 0), cA + kstep, voffA); PG8_STAGE(PG8_SB(1, 1), cB + hstep + kstep, voffB);
        PG8_WAIT_V(6); PG8_BAR;
    }
    for (;;) {
        const bool has_next = S.next(ui + 1, nxt);
        const char* nA = has_next ? (const char*)g.A + (size_t)nxt.pm * tstep : cA; const char* nB = has_next ? (const char*)g.Bt + (size_t)nxt.pn * tstep : cB;
        for (int t = 0; t < nt; t += 2) {
            const bool last = (t == nt - 2);
            const char* a1 = cA + (size_t)(t + 1) * kstep;
            const char* a2 = last ? nA : cA + (size_t)(t + 2) * kstep; const char* b2 = last ? nB : cB + (size_t)(t + 2) * kstep;
            const char* a3 = a2 + kstep; const char* b3 = b2 + kstep;
            if (last && has_next) S.a_ready(nxt);
            if constexpr (SP2) {
            PG8_LDB(B0, 0, 0); PG8_LDB(B1, 0, 1); PG8_SCHED; PG8_LDA(At, 0, 0); PG8_STAGE(PG8_SA(1, 1), a1 + hstep, voffA);
            PG8_WAIT_V(8); PG8_WAIT_L(0); PG8_BAR; PG8_MMA(0, 0, At, B0); PG8_MMA(0, 1, At, B1); PG8_BAR; PG8_SCHED;
            PG8_LDA(At, 0, 1); PG8_STAGE(PG8_SB(0, 0), b2, voffB); PG8_STAGE(PG8_SB(0, 1), b2 + hstep, voffB); PG8_STAGE(PG8_SA(0, 0), a2, voffA);
            PG8_WAIT_V(8); PG8_WAIT_L(0); PG8_BAR; PG8_MMA(1, 0, At, B0); PG8_MMA(1, 1, At, B1); PG8_BAR; PG8_SCHED;
            PG8_LDB(B0, 1, 0); PG8_LDB(B1, 1, 1); PG8_SCHED; PG8_LDA(At, 1, 0); PG8_STAGE(PG8_SA(0, 1), a2 + hstep, voffA);
            PG8_WAIT_V(8); PG8_WAIT_L(0); PG8_BAR; PG8_MMA(0, 0, At, B0); PG8_MMA(0, 1, At, B1); PG8_BAR; PG8_SCHED;
            PG8_LDA(At, 1, 1); PG8_STAGE(PG8_SB(1, 0), b3, voffB); PG8_STAGE(PG8_SB(1, 1), b3 + hstep, voffB); PG8_STAGE(PG8_SA(1, 0), a3, voffA);
            PG8_WAIT_V(8); PG8_WAIT_L(0); PG8_BAR; PG8_MMA(1, 0, At, B0); PG8_MMA(1, 1, At, B1); PG8_BAR; PG8_SCHED;
            } else {
            PG8_LDB(B0, 0, 0); PG8_SCHED; PG8_LDA(At, 0, 0); PG8_STAGE(PG8_SA(1, 1), a1 + hstep, voffA);
            PG8_WAIT_L(8); PG8_BAR; PG8_WAIT_L(0); PG8_MMA(0, 0, At, B0); PG8_BAR; PG8_SCHED;
            PG8_LDB(B1, 0, 1); PG8_STAGE(PG8_SB(0, 0), b2, voffB);
            PG8_BAR; PG8_WAIT_L(0); PG8_MMA(0, 1, At, B1); PG8_BAR;
            PG8_LDA(At, 0, 1); PG8_STAGE(PG8_SA(0, 0), a2, voffA);
            PG8_BAR; PG8_WAIT_L(0); PG8_MMA(1, 0, At, B0); PG8_BAR; PG8_SCHED;
            PG8_STAGE(PG8_SB(0, 1), b2 + hstep, voffB);
            PG8_WAIT_V(6); PG8_BAR; PG8_MMA(1, 1, At, B1); PG8_BAR;
            PG8_LDB(B0, 1, 0); PG8_SCHED; PG8_LDA(At, 1, 0); PG8_STAGE(PG8_SA(0, 1), a2 + hstep, voffA);
            PG8_WAIT_L(8); PG8_BAR; PG8_WAIT_L(0); PG8_MMA(0, 0, At, B0); PG8_BAR; PG8_SCHED;
            PG8_LDB(B1, 1, 1); PG8_STAGE(PG8_SB(1, 0), b3, voffB);
            PG8_BAR; PG8_WAIT_L(0); PG8_MMA(0, 1, At, B1); PG8_BAR;
            PG8_LDA(At, 1, 1); PG8_STAGE(PG8_SA(1, 0), a3, voffA);
            PG8_BAR; PG8_WAIT_L(0); PG8_MMA(1, 0, At, B0); PG8_BAR; PG8_SCHED;
            PG8_STAGE(PG8_SB(1, 1), b3 + hstep, voffB);
            PG8_WAIT_V(6); PG8_BAR; PG8_MMA(1, 1, At, B1); PG8_BAR;
            }
        }
        if constexpr (ALIGN_EPI) { if (wr == 0) PG8_BAR; }
        if constexpr (!Epi::AFTER_DRAIN) { E(acc, cur, wr, wc, fr, fq); S.done(cur); }
        if (!has_next) break;
#pragma unroll
        for (int a = 0; a < 2; ++a)
#pragma unroll
            for (int b = 0; b < 2; ++b)
#pragma unroll
                for (int m = 0; m < 4; ++m)
#pragma unroll
                    for (int n = 0; n < 2; ++n) acc[a][b][m][n] = (f32x4){0.f, 0.f, 0.f, 0.f};
        cur = nxt; cA = nA; cB = nB; ++ui;
        if constexpr (ALIGN_EPI) { if (wr == 1) PG8_BAR; }
    }
    PG8_WAIT_V(0);
    if constexpr (!ALIGN_EPI) { if (wr == 0) PG8_BAR; }
    PG8_BAR;
    if constexpr (Epi::AFTER_DRAIN) { E.fused(acc, cur, wr, wc, fr, fq, lds, wid, lane); S.done(cur); }
#undef PG8_SA
#undef PG8_SB
#undef PG8_STAGE
#undef PG8_LDA
#undef PG8_LDB
#undef PG8_MMA
#undef PG8_WAIT_V
#undef PG8_WAIT_L
#undef PG8_BAR
#undef PG8_SCHED
}
}

#define LAS __attribute__((address_space(3)))
typedef unsigned short bf16_t;
typedef short bf16x8 __attribute__((ext_vector_type(8)));
typedef float f32x4 __attribute__((ext_vector_type(4)));
typedef float f32x2 __attribute__((ext_vector_type(2)));
typedef float f32x16 __attribute__((ext_vector_type(16)));
typedef unsigned u32x4 __attribute__((ext_vector_type(4)));
typedef unsigned u32x2 __attribute__((ext_vector_type(2)));
#define LDS_WAIT() asm volatile("s_waitcnt lgkmcnt(0)" ::: "memory")
__device__ __forceinline__ int opaque_tid() { int t = threadIdx.x; asm volatile("" : "+v"(t)); return t; }
using pg8::cvt_pk_bf16;
__device__ __forceinline__ float bf2f(unsigned v16) { return __uint_as_float(v16 << 16); }
__device__ __forceinline__ float fexp2(float x) { return __builtin_amdgcn_exp2f(x); }
__device__ __forceinline__ float frcp(float x) { return __builtin_amdgcn_rcpf(x); }
__device__ __forceinline__ float fsigmoid(float x) { return frcp(1.0f + fexp2(-LOG2E * x)); }
__device__ __forceinline__ float wave_sum(float v) {
#pragma unroll
    for (int o = 1; o < 64; o <<= 1) v += __shfl_xor(v, o);
    return v;
}

constexpr size_t MiB = 1u << 20;
constexpr size_t WS_WIN = 1 * MiB, WS_WOUT = 15 * MiB, WS_WFI = 23 * MiB, WS_WFO = 67 * MiB, WS_WG = 89 * MiB, WS_MOD = 90 * MiB, WS_SHW1 = 92 * MiB, WS_SHW2 = 93 * MiB,
                 WS_RSQ1 = 95 * MiB, WS_RSQ2 = 98 * MiB, WS_AGG = 101 * MiB, WS_CLAM = 107 * MiB, WS_HB = 108 * MiB, WS_Z = 204 * MiB, WS_MIX = 372 * MiB, WS_HID = 204 * MiB, WS_END = 468 * MiB;
constexpr int LDS_BYTES = 151552;

struct Args { const float* in[23]; float* out; unsigned char* ws; int pad0, pad1; };

template <int MODE> __device__ __forceinline__ void transpose_item(const float* W, int K, int N, bf16_t* WT, LAS float* scr, int item, int lane) {
    const int nblk = N / 32, kb = item / nblk, nb = item % nblk, k0 = 64 * kb, n0 = 32 * nb;
    float tv[32];
#pragma unroll
    for (int i = 0; i < 32; ++i) tv[i] = W[(size_t)(k0 + 2 * i + (lane >> 5)) * N + n0 + (lane & 31)];
#pragma unroll
    for (int i = 0; i < 32; ++i) scr[(2 * i + (lane >> 5)) * 33 + (lane & 31)] = tv[i];
    LDS_WAIT();
    int drow0 = n0;
    if (MODE == 1) { const int half = n0 >= DFF ? 1 : 0; const int j = n0 - half * DFF; drow0 = (j >> 7) * 256 + half * 128 + (j & 127); }
    const int c = lane & 7;
#pragma unroll
    for (int j = 0; j < 4; ++j) { const int n = (lane >> 3) + 8 * j; const LAS float* s = scr + (8 * c) * 33 + n;
        u32x4 o; o.x = cvt_pk_bf16(s[0 * 33], s[1 * 33]); o.y = cvt_pk_bf16(s[2 * 33], s[3 * 33]); o.z = cvt_pk_bf16(s[4 * 33], s[5 * 33]); o.w = cvt_pk_bf16(s[6 * 33], s[7 * 33]);
        *(u32x4*)(WT + (size_t)(drow0 + n) * K + k0 + 8 * c) = o; }
    LDS_WAIT();
}

__device__ __forceinline__ void gemv20_item(const float* W, int ldw, int srccol0, LAS const float* vl, LAS float* red, float* out, int ostride, int dstcol0, const float* bias) {
    const int tid = opaque_tid(), cl = tid & 63, kg = tid >> 6;
    float acc[NB];
#pragma unroll
    for (int b = 0; b < NB; ++b) acc[b] = 0.f;
    const float* wp = W + (size_t)(kg * 128) * ldw + srccol0 + cl;
    LAS const f32x4* vp = (LAS const f32x4*)(vl + kg * 128 * NB);
#pragma unroll 1
    for (int k0 = 0; k0 < 128; k0 += 32) { float wv[32];
#pragma unroll
        for (int kk = 0; kk < 32; ++kk) wv[kk] = wp[(size_t)(k0 + kk) * ldw];
#pragma unroll
        for (int kk = 0; kk < 32; ++kk) { const float w = wv[kk];
#pragma unroll
            for (int q = 0; q < 5; ++q) { const f32x4 v = vp[(k0 + kk) * 5 + q]; acc[4 * q] += v[0] * w; acc[4 * q + 1] += v[1] * w; acc[4 * q + 2] += v[2] * w; acc[4 * q + 3] += v[3] * w; } } }
#pragma unroll
    for (int b = 0; b < NB; ++b) red[(kg * NB + b) * 64 + cl] = acc[b];
    __syncthreads();
    for (int o = tid; o < NB * 64; o += 512) { const int b = o >> 6, c = o & 63; float s = 0.f;
#pragma unroll
        for (int g = 0; g < 8; ++g) s += red[(g * NB + b) * 64 + c];
        if (bias) s += bias[dstcol0 + c];
        out[(size_t)b * ostride + dstcol0 + c] = s; }
    __syncthreads();
}

constexpr int YPITCH = 1040;
__device__ __forceinline__ void rms_store(LAS const unsigned char* Yl, const float* g, bf16_t* dst) {
    const int tid = opaque_tid(), tok = tid >> 3, sub = tid & 7;
    u32x4 v[8]; float ss = 0.f;
#pragma unroll
    for (int j = 0; j < 8; ++j) { v[j] = *(LAS const u32x4*)(Yl + tok * YPITCH + (j * 8 + sub) * 16);
#pragma unroll
        for (int e = 0; e < 4; ++e) { const float a = bf2f(v[j][e] & 0xffffu), b = __uint_as_float(v[j][e] & 0xffff0000u); ss += a * a + b * b; } }
    ss += __shfl_xor(ss, 1); ss += __shfl_xor(ss, 2); ss += __shfl_xor(ss, 4);
    const float rs = rsqrtf(ss * (1.0f / 512.0f) + EPS);
#pragma unroll
    for (int j = 0; j < 8; ++j) { const int c = (j * 8 + sub) * 8; const f32x4 g0 = *(const f32x4*)(g + c), g1 = *(const f32x4*)(g + c + 4);
        u32x4 o;
        o.x = cvt_pk_bf16(bf2f(v[j][0] & 0xffffu) * rs * g0[0], __uint_as_float(v[j][0] & 0xffff0000u) * rs * g0[1]);
        o.y = cvt_pk_bf16(bf2f(v[j][1] & 0xffffu) * rs * g0[2], __uint_as_float(v[j][1] & 0xffff0000u) * rs * g0[3]);
        o.z = cvt_pk_bf16(bf2f(v[j][2] & 0xffffu) * rs * g1[0], __uint_as_float(v[j][2] & 0xffff0000u) * rs * g1[1]);
        o.w = cvt_pk_bf16(bf2f(v[j][3] & 0xffffu) * rs * g1[2], __uint_as_float(v[j][3] & 0xffff0000u) * rs * g1[3]);
        *(u32x4*)(dst + (size_t)tok * DM + c) = o; }
}

__device__ __forceinline__ int crow(int r, int hi) { return (r & 3) + 8 * (r >> 2) + 4 * hi; }
__device__ __forceinline__ bf16x8 pack8(float a0, float a1, float a2, float a3, float a4, float a5, float a6, float a7) {
    u32x4 w; w.x = cvt_pk_bf16(a0, a1); w.y = cvt_pk_bf16(a2, a3); w.z = cvt_pk_bf16(a4, a5); w.w = cvt_pk_bf16(a6, a7); return __builtin_bit_cast(bf16x8, w);
}

constexpr int KPITCH = 144;
__device__ __forceinline__ void attn_unit(int cgi, const bf16_t* __restrict__ z, bf16_t* mix, const float* sink_l, const float* g_l, LAS unsigned char* lds) {
    const int tid = opaque_tid(), lane = tid & 63, r32 = lane & 31, hi = lane >> 5, h = __builtin_amdgcn_readfirstlane(tid >> 6), kv = h >> 2;
    const int row0 = cgi * 64, b = row_batch(row0), S = batch_len(b), seq0 = batch_row0(b), t0 = row0 - seq0, qb = t0 >> 6, nkb = S >> 6;
    const int kb_lo = qb - 2 < 0 ? 0 : qb - 2, kb_hi = qb + 2 > nkb - 1 ? nkb - 1 : qb + 2;
    LAS unsigned char* Yl = lds + 73728;
    __syncthreads();
#pragma unroll
    for (int qt = 0; qt < 2; ++qt)
#pragma unroll
        for (int d0 = 0; d0 < 4; ++d0) { const u32x4 qv = *(const u32x4*)(z + (size_t)(row0 + 32 * qt + r32) * DIN + h * 64 + d0 * 16 + hi * 8);
            *(LAS u32x4*)(Yl + (32 * qt + r32) * YPITCH + (h * 64 + d0 * 16 + hi * 8) * 2) = qv; }
    LDS_WAIT();
    const float slope2 = fexp2(-(float)(h + 1)) * LOG2E, sc2 = 0.125f * LOG2E;
    float mrun[2], lrun[2]; f32x16 o[2][2];
#pragma unroll
    for (int qt = 0; qt < 2; ++qt) { mrun[qt] = sink_l[h] * LOG2E; lrun[qt] = hi ? 0.f : 1.f;
#pragma unroll
        for (int dh = 0; dh < 2; ++dh)
#pragma unroll
            for (int r = 0; r < 16; ++r) o[qt][dh][r] = 0.f; }
    const int s_key = tid >> 3, s_dch = tid & 7, v_kv = tid >> 8, v_dch = (tid >> 5) & 7, v_pair = tid & 31;
    u32x4 kreg[2], vreg[2];
#define ATT_LOAD(kb) do { const int krow = seq0 + (kb) * 64; \
        _Pragma("unroll") for (int i = 0; i < 2; ++i) { kreg[i] = *(const u32x4*)(z + (size_t)(krow + s_key) * DIN + 512 + i * 64 + s_dch * 8); \
            vreg[i] = *(const u32x4*)(z + (size_t)(krow + 2 * v_pair + i) * DIN + 640 + v_kv * 64 + v_dch * 8); } } while (0)
#define ATT_STORE(bufp) do { LAS unsigned char* Ks_ = (bufp); LAS unsigned char* Vs_ = (bufp) + 18432; \
        _Pragma("unroll") for (int i = 0; i < 2; ++i) *(LAS u32x4*)(Ks_ + (i * 64 + s_key) * KPITCH + s_dch * 16) = kreg[i]; \
        _Pragma("unroll") for (int e = 0; e < 8; ++e) { const unsigned w0 = vreg[0][e >> 1], w1 = vreg[1][e >> 1]; \
            const unsigned lo = (e & 1) ? (w0 >> 16) : (w0 & 0xffffu), hh = (e & 1) ? (w1 & 0xffff0000u) : (w1 << 16); \
            *(LAS unsigned*)(Vs_ + (v_kv * 64 + v_dch * 8 + e) * KPITCH + v_pair * 4) = lo | hh; } } while (0)
    ATT_LOAD(kb_lo);
    ATT_STORE(lds);
    __syncthreads();
    int cur = 0;
    for (int kb = kb_lo; kb <= kb_hi; ++kb) {
        LAS unsigned char* Kl = lds + cur * 36864; LAS unsigned char* Vl = Kl + 18432;
        if (kb < kb_hi) ATT_LOAD(kb + 1);
        const bool edge = (kb - qb == 2) || (qb - kb == 2);
        f32x16 pp[2][2];
#pragma unroll
        for (int qt = 0; qt < 2; ++qt) {
#pragma unroll
            for (int r = 0; r < 16; ++r) { pp[qt][0][r] = 0.f; pp[qt][1][r] = 0.f; }
#pragma unroll
            for (int d0 = 0; d0 < 4; ++d0) {
                const bf16x8 k0f = *(LAS const bf16x8*)(Kl + (kv * 64 + r32) * KPITCH + (16 * d0 + 8 * hi) * 2);
                const bf16x8 k1f = *(LAS const bf16x8*)(Kl + (kv * 64 + 32 + r32) * KPITCH + (16 * d0 + 8 * hi) * 2);
                const bf16x8 qf = *(LAS const bf16x8*)(Yl + (32 * qt + r32) * YPITCH + (h * 64 + d0 * 16 + hi * 8) * 2);
                pp[qt][0] = __builtin_amdgcn_mfma_f32_32x32x16_bf16(k0f, qf, pp[qt][0], 0, 0, 0);
                pp[qt][1] = __builtin_amdgcn_mfma_f32_32x32x16_bf16(k1f, qf, pp[qt][1], 0, 0, 0);
            }
        }
        __builtin_amdgcn_sched_barrier(0);
#pragma unroll
        for (int qt = 0; qt < 2; ++qt) {
            f32x16& p0 = pp[qt][0]; f32x16& p1 = pp[qt][1];
            float dbase = (float)(t0 + 32 * qt + r32 - kb * 64 - 4 * hi); asm volatile("" : "+v"(dbase));
            const float nslope = -slope2, nref = -mrun[qt];
            float bm = -1e30f;
#pragma unroll
            for (int r = 0; r < 16; ++r) { const float d_0 = dbase - (float)((r & 3) + 8 * (r >> 2)), d_1 = dbase - (float)((r & 3) + 8 * (r >> 2) + 32); float t0_, t1_;
                asm("v_fma_f32 %0, |%1|, %2, %3" : "=v"(t0_) : "v"(d_0), "v"(nslope), "v"(nref));
                asm("v_fma_f32 %0, |%1|, %2, %3" : "=v"(t1_) : "v"(d_1), "v"(nslope), "v"(nref));
                p0[r] = __builtin_fmaf(p0[r], sc2, t0_); p1[r] = __builtin_fmaf(p1[r], sc2, t1_); }
            if (edge) {
#pragma unroll
                for (int r = 0; r < 16; ++r) { const float d_0 = dbase - (float)((r & 3) + 8 * (r >> 2)), d_1 = dbase - (float)((r & 3) + 8 * (r >> 2) + 32);
                    p0[r] = __builtin_fabsf(d_0) <= 128.0f ? p0[r] : -1e30f; p1[r] = __builtin_fabsf(d_1) <= 128.0f ? p1[r] : -1e30f; }
            }
#pragma unroll
            for (int r = 0; r < 16; ++r) bm = fmaxf(bm, fmaxf(p0[r], p1[r]));
            bm = fmaxf(bm, __shfl_xor(bm, 32));
            if (__any(bm > 0.f)) {
                const float dl = fmaxf(bm, 0.f), alpha = fexp2(-dl); mrun[qt] += dl; lrun[qt] *= alpha;
#pragma unroll
                for (int r = 0; r < 16; ++r) { p0[r] -= dl; p1[r] -= dl; }
#pragma unroll
                for (int dh = 0; dh < 2; ++dh)
#pragma unroll
                    for (int r = 0; r < 16; ++r) o[qt][dh][r] *= alpha;
            }
            { float ls = 0.f;
#pragma unroll
              for (int r = 0; r < 16; ++r) { p0[r] = fexp2(p0[r]); p1[r] = fexp2(p1[r]); ls += p0[r] + p1[r]; }
              lrun[qt] += ls; }
            __builtin_amdgcn_sched_barrier(0);
            bf16x8 pf[4];
            pf[0] = pack8(p0[0], p0[1], p0[2], p0[3], p0[4], p0[5], p0[6], p0[7]); pf[1] = pack8(p0[8], p0[9], p0[10], p0[11], p0[12], p0[13], p0[14], p0[15]);
            pf[2] = pack8(p1[0], p1[1], p1[2], p1[3], p1[4], p1[5], p1[6], p1[7]); pf[3] = pack8(p1[8], p1[9], p1[10], p1[11], p1[12], p1[13], p1[14], p1[15]);
#pragma unroll
            for (int ks = 0; ks < 4; ++ks)
#pragma unroll
                for (int dh = 0; dh < 2; ++dh) {
                    LAS const unsigned char* vp = Vl + (kv * 64 + 32 * dh + r32) * KPITCH + (16 * ks + 4 * hi) * 2;
                    const u32x2 a = *(LAS const u32x2*)vp, c = *(LAS const u32x2*)(vp + 16);
                    const u32x4 vv = {a.x, a.y, c.x, c.y};
                    o[qt][dh] = __builtin_amdgcn_mfma_f32_32x32x16_bf16(__builtin_bit_cast(bf16x8, vv), pf[ks], o[qt][dh], 0, 0, 0);
                }
        }
        if (kb < kb_hi) ATT_STORE(lds + (cur ^ 1) * 36864);
        __syncthreads();
        cur ^= 1;
    }
#undef ATT_LOAD
#undef ATT_STORE
    LDS_WAIT();
#pragma unroll
    for (int qt = 0; qt < 2; ++qt) { const float lt = lrun[qt] + __shfl_xor(lrun[qt], 32), inv = 1.0f / lt;
#pragma unroll
        for (int dh = 0; dh < 2; ++dh)
#pragma unroll
            for (int r4 = 0; r4 < 4; ++r4) { u32x2 w; w.x = cvt_pk_bf16(o[qt][dh][4 * r4] * inv, o[qt][dh][4 * r4 + 1] * inv); w.y = cvt_pk_bf16(o[qt][dh][4 * r4 + 2] * inv, o[qt][dh][4 * r4 + 3] * inv);
                *(LAS u32x2*)(Yl + (32 * qt + r32) * YPITCH + (h * 64 + 32 * dh + 8 * r4 + 4 * hi) * 2) = w; } }
    __syncthreads();
    rms_store(Yl, g_l, mix + (size_t)row0 * DM);
    __syncthreads();
}

struct LruP { const float *conv_w, *conv_b, *b_rg, *b_ig, *lam, *g_lru; const bf16_t* wg; };
template <int DIR> __device__ __forceinline__ void scan32(const f32x16& A, const f32x16& U, float& c, float& Atot, int hi, float (&hsv)[16]) {
    float Ag[4], Hg[4], oA[4], oH[4], cin[4];
#pragma unroll
    for (int gi = 0; gi < 4; ++gi) { const float a0 = A[4 * gi], a1 = A[4 * gi + 1], a2 = A[4 * gi + 2], a3 = A[4 * gi + 3], u0 = U[4 * gi], u1 = U[4 * gi + 1], u2 = U[4 * gi + 2], u3 = U[4 * gi + 3];
        Ag[gi] = (a0 * a1) * (a2 * a3); float hh;
        if (DIR == 0) { hh = u0; hh = a1 * hh + u1; hh = a2 * hh + u2; hh = a3 * hh + u3; } else { hh = u3; hh = a2 * hh + u2; hh = a1 * hh + u1; hh = a0 * hh + u0; }
        Hg[gi] = hh; oA[gi] = __shfl_xor(Ag[gi], 32); oH[gi] = __shfl_xor(hh, 32); }
#pragma unroll
    for (int g_ = 0; g_ < 4; ++g_) { const int gi = DIR == 0 ? g_ : 3 - g_;
        const float AE = hi ? oA[gi] : Ag[gi], HE = hi ? oH[gi] : Hg[gi], AO = hi ? Ag[gi] : oA[gi], HO = hi ? Hg[gi] : oH[gi];
        float ce, co;
        if (DIR == 0) { ce = c; c = AE * c + HE; co = c; c = AO * c + HO; } else { co = c; c = AO * c + HO; ce = c; c = AE * c + HE; }
        cin[gi] = hi ? co : ce; Atot *= AE * AO; }
#pragma unroll
    for (int gi = 0; gi < 4; ++gi) { float hh = cin[gi];
#pragma unroll
        for (int j_ = 0; j_ < 4; ++j_) { const int j = DIR == 0 ? j_ : 3 - j_; hh = A[4 * gi + j] * hh + U[4 * gi + j]; hsv[4 * gi + j] += hh; } }
}
template <bool FINAL> __device__ __forceinline__ void lru_unit(int cgi, const bf16_t* __restrict__ z, bf16_t* mix, const LruP P, f32x2* agg, LAS unsigned char* lds) {
    const int tid = opaque_tid(), lane = tid & 63, r32 = lane & 31, hi = lane >> 5, w = __builtin_amdgcn_readfirstlane(tid >> 6), c0 = 64 * w;
    const int row0 = cgi * 64, b = row_batch(row0), S = batch_len(b), seq0 = batch_row0(b), t0 = row0 - seq0, ch = t0 >> 6, nch = S >> 6, chunkbase = cgi - ch;
    LAS unsigned char* XC = lds + w * 9648; LAS unsigned char* Yl = lds + 77184;
    LAS float* CAR = (LAS float*)(lds + 143744) + w * 128;
    u32x4 raw[9];
#pragma unroll
    for (int i = 0; i < 9; ++i) { const int idx = i * 64 + lane, t = idx >> 3, chunk = idx & 7, tok = t0 - 2 + t;
        raw[i] = (u32x4){0u, 0u, 0u, 0u};
        if (t < 67 && tok >= 0 && tok < S) raw[i] = *(const u32x4*)(z + (size_t)(seq0 + tok) * DIN + 768 + c0 + chunk * 8); }
    if (FINAL) {
        u32x4 graw[8];
#pragma unroll
        for (int i = 0; i < 8; ++i) { const int idx = i * 64 + lane, t = idx >> 3, chunk = idx & 7; graw[i] = *(const u32x4*)(z + (size_t)(row0 + t) * DIN + 1280 + c0 + chunk * 8); }
#pragma unroll
        for (int i = 0; i < 8; ++i) { const int idx = i * 64 + lane, t = idx >> 3, chunk = idx & 7; *(LAS u32x4*)(Yl + t * YPITCH + (c0 + chunk * 8) * 2) = graw[i]; }
    }
    const int cc = c0 + lane; const float cb = P.conv_b[cc], w0 = P.conv_w[cc], w1 = P.conv_w[512 + cc], w2 = P.conv_w[1024 + cc], w3 = P.conv_w[1536 + cc];
    bf16x8 wf[2][8]; float bb[2][3];
#define LRU_LOADW(buf, mt_, dir_) do { const bf16_t* wp_ = P.wg + ((size_t)(((dir_) * 2) * 8 + w) * 64 + 32 * (mt_) + r32) * 64 + hi * 8; \
        _Pragma("unroll") for (int ks = 0; ks < 4; ++ks) { wf[buf][ks] = *(const bf16x8*)(wp_ + ks * 16); wf[buf][4 + ks] = *(const bf16x8*)(wp_ + 8 * 64 * 64 + ks * 16); } \
        const int chn_ = c0 + 32 * (mt_) + r32; bb[buf][0] = P.b_rg[(dir_) * 512 + chn_]; bb[buf][1] = P.b_ig[(dir_) * 512 + chn_]; bb[buf][2] = P.lam[(dir_) * 512 + chn_]; } while (0)
    LRU_LOADW(0, 0, 0);
    if (FINAL) {
        float cf = 0.f, cbk = 0.f;
        const f32x2* ap = agg + (size_t)chunkbase * 1024 + cc;
#pragma unroll 8
        for (int j = 0; j < ch; ++j) { const f32x2 ah = ap[(size_t)j * 1024]; cf = ah.x * cf + ah.y; }
#pragma unroll 8
        for (int j = nch - 1; j > ch; --j) { const f32x2 ah = ap[(size_t)j * 1024 + 512]; cbk = ah.x * cbk + ah.y; }
        CAR[lane] = cf; CAR[64 + lane] = cbk;
    }
#pragma unroll
    for (int i = 0; i < 9; ++i) { const int idx = i * 64 + lane, t = idx >> 3, chunk = idx & 7; if (t < 67) *(LAS u32x4*)(XC + t * KPITCH + chunk * 16) = raw[i]; }
    LDS_WAIT();
    {
#define XLD(r) bf2f(*(LAS const unsigned short*)(XC + (r) * KPITCH + lane * 2))
        float a0 = XLD(0), a1 = XLD(1), a2 = XLD(2);
#pragma unroll 16
        for (int t = 0; t < 64; ++t) { const float a3 = XLD(t + 3); const float xc = cb + w0 * a0 + w1 * a1 + w2 * a2 + w3 * a3;
            *(LAS unsigned short*)(XC + t * KPITCH + lane * 2) = (unsigned short)(cvt_pk_bf16(xc, 0.f) & 0xffffu); a0 = a1; a1 = a2; a2 = a3; }
#undef XLD
        LDS_WAIT();
    }
#pragma unroll
    for (int mt = 0; mt < 2; ++mt) {
        const int chn = c0 + 32 * mt + r32;
        float hs[2][16];
#pragma unroll
        for (int s = 0; s < 2; ++s)
#pragma unroll
            for (int r = 0; r < 16; ++r) hs[s][r] = 0.f;
#pragma unroll
        for (int dir = 0; dir < 2; ++dir) {
            const int step = 2 * mt + dir, cur = step & 1;
            if (step < 3) LRU_LOADW(cur ^ 1, (step + 1) >> 1, (step + 1) & 1);
            __builtin_amdgcn_sched_barrier(0);
            const float brg = -LOG2E * bb[cur][0], big = -LOG2E * bb[cur][1], clam = bb[cur][2];
            float c = 0.f, Atot = 1.f;
            if (FINAL) c = CAR[dir * 64 + 32 * mt + r32];
#pragma unroll
            for (int si = 0; si < 2; ++si) { const int s = dir ? 1 - si : si;
                __builtin_amdgcn_sched_barrier(0);
                f32x16 accr, acci;
#pragma unroll
                for (int r = 0; r < 16; ++r) { accr[r] = 0.f; acci[r] = 0.f; }
#pragma unroll
                for (int ks = 0; ks < 4; ++ks) { const bf16x8 af = *(LAS const bf16x8*)(XC + (32 * s + r32) * KPITCH + (16 * ks + 8 * hi) * 2);
                    accr = __builtin_amdgcn_mfma_f32_32x32x16_bf16(af, wf[cur][ks], accr, 0, 0, 0); acci = __builtin_amdgcn_mfma_f32_32x32x16_bf16(af, wf[cur][4 + ks], acci, 0, 0, 0); }
#pragma unroll
                for (int r = 0; r < 16; ++r) { const float xv = bf2f(*(LAS const unsigned short*)(XC + (32 * s + crow(r, hi)) * KPITCH + (32 * mt + r32) * 2));
                    const float rr = frcp(1.0f + fexp2(__builtin_fmaf(accr[r], -LOG2E, brg))), ii = frcp(1.0f + fexp2(__builtin_fmaf(acci[r], -LOG2E, big))), a = fexp2(rr * clam);
                    accr[r] = a; acci[r] = __builtin_amdgcn_sqrtf(fmaxf(1.0f - a * a, 0.f)) * ii * xv; }
                if (dir == 0) scan32<0>(accr, acci, c, Atot, hi, hs[s]); else scan32<1>(accr, acci, c, Atot, hi, hs[s]);
            }
            if (!FINAL) { if (hi == 0) agg[((size_t)cgi * 2 + dir) * 512 + chn] = (f32x2){Atot, c}; }
        }
        if (FINAL) {
#pragma unroll
            for (int s = 0; s < 2; ++s) { __builtin_amdgcn_sched_barrier(0);
#pragma unroll
                for (int r = 0; r < 16; ++r) { const int t = 32 * s + crow(r, hi); const float gte = bf2f(*(LAS const unsigned short*)(Yl + t * YPITCH + chn * 2));
                    const float ge = gte * frcp(1.0f + fexp2(-LOG2E * 1.5957691216f * (gte + 0.044715f * gte * gte * gte)));
                    *(LAS unsigned short*)(Yl + t * YPITCH + chn * 2) = (unsigned short)(cvt_pk_bf16(hs[s][r] * ge, 0.f) & 0xffffu); } }
        }
    }
#undef LRU_LOADW
    if (FINAL) {
        __syncthreads();
        rms_store(Yl, P.g_lru, mix + (size_t)row0 * DM + 512);
        __syncthreads();
    }
}

#define RLX_AGENT __ATOMIC_RELAXED, __HIP_MEMORY_SCOPE_AGENT
#define XB_TMO      128
#define XB_XCNT(j)  (256  + 64 * (j))
#define XB_XSUB(j)  (1280 + 64 * (j))
#define XB_XGEN(j)  (2304 + 64 * (j))
#define XB_TOP      3328
#define XB_TOPGEN   3392
#define XCD_BAR_WORDS 3456
#define XB_SPIN_CAP (1u << 18)

__device__ __forceinline__ unsigned xb_ld(unsigned* p)              { return __hip_atomic_load(p, __ATOMIC_RELAXED, __HIP_MEMORY_SCOPE_AGENT); }
__device__ __forceinline__ unsigned xb_add(unsigned* p, unsigned v) { return __hip_atomic_fetch_add(p, v, __ATOMIC_RELAXED, __HIP_MEMORY_SCOPE_AGENT); }
__device__ __forceinline__ unsigned xb_xcc_id() { return (unsigned)__builtin_amdgcn_s_getreg((3 << 11) | 20) & 0xFu; }
#define XB_SPIN(cond, bar) do { unsigned _sp = 0; while (cond) { __builtin_amdgcn_s_sleep(1); \
    if ((++_sp & 255u) == 0u) { if (xb_ld(&(bar)[XB_TMO])) break; if (_sp > XB_SPIN_CAP) { atomicAdd(&(bar)[XB_TMO], 1u); break; } } } } while (0)

struct XcdBarrier {
    unsigned* bar; unsigned x;
    volatile LAS unsigned* st;
};

__device__ __forceinline__ XcdBarrier xcd_barrier_post(unsigned* bar, volatile LAS unsigned* st) {
    XcdBarrier b; b.bar = bar; b.x = xb_xcc_id(); b.st = st;
    if (threadIdx.x == 0) (void)xb_add(&bar[XB_XCNT(b.x)], 1u);
    return b;
}
__device__ __forceinline__ void xcd_barrier_complete(unsigned* bar, unsigned x, unsigned& nloc, unsigned& nx) {
    const unsigned G = gridDim.x * gridDim.y * gridDim.z;
    unsigned sum, cnt, mine, sp = 0u;
    for (;;) {
        sum = 0u; cnt = 0u; mine = 0u;
#pragma unroll
        for (unsigned j = 0; j < 16; ++j) { const unsigned c = xb_ld(&bar[XB_XCNT(j)]); sum += c; cnt += (c > 0u) ? 1u : 0u; mine = (j == x) ? c : mine; }
        if (sum == G) break;
        __builtin_amdgcn_s_sleep(1);
        if ((++sp & 255u) == 0u) { if (xb_ld(&bar[XB_TMO])) break; if (sp > XB_SPIN_CAP) { atomicAdd(&bar[XB_TMO], 1u); break; } }
    }
    nloc = mine > 0u ? mine : 1u; nx = cnt > 0u ? cnt : 1u;
}

__device__ __forceinline__ void xcd_barrier(const XcdBarrier& b) {
    asm volatile("s_waitcnt vmcnt(0)" ::: "memory");
    __syncthreads();
    if (threadIdx.x == 0) {
        unsigned* bar = b.bar; const unsigned bx_ = xb_xcc_id();
        __builtin_amdgcn_s_waitcnt(0);
        unsigned nloc = b.st[0], nx = b.st[1];
        if (nloc == 0u) { xcd_barrier_complete(bar, bx_, nloc, nx); b.st[0] = nloc; b.st[1] = nx; }
        const unsigned old = xb_add(&bar[XB_XSUB(bx_)], 1u);
        const unsigned gen = old / nloc;
        if (old + 1u == (gen + 1u) * nloc) {
            __builtin_amdgcn_fence(__ATOMIC_RELEASE, "agent");
            asm volatile("s_waitcnt vmcnt(0)" ::: "memory");
            const unsigned og = xb_add(&bar[XB_TOP], 1u);
            const unsigned tg = og / nx;
            if (og + 1u == (tg + 1u) * nx) xb_add(&bar[XB_TOPGEN], 1u);
            else XB_SPIN(xb_ld(&bar[XB_TOPGEN]) == tg, bar);
            __builtin_amdgcn_fence(__ATOMIC_ACQUIRE, "agent");
            xb_add(&bar[XB_XGEN(bx_)], 1u);
            asm volatile("s_waitcnt vmcnt(0)" ::: "memory");
        } else {
            XB_SPIN(xb_ld(&bar[XB_XGEN(bx_)]) == gen, bar);
            __builtin_amdgcn_fence(__ATOMIC_ACQUIRE, "agent");
            asm volatile("s_waitcnt vmcnt(0)" ::: "memory");
        }
    }
    __syncthreads();
}

#ifndef EN_P0
#define EN_P0 1
#endif
#ifndef EN_P1
#define EN_P1 1
#endif
#ifndef EN_G1
#define EN_G1 1
#endif
#ifndef EN_G2
#define EN_G2 1
#endif
#ifndef EN_G3
#define EN_G3 1
#endif
#ifndef EN_G4
#define EN_G4 1
#endif
#ifndef EN_ATT
#define EN_ATT 1
#endif
#ifndef EN_LRUA
#define EN_LRUA 1
#endif
#ifndef EN_LRUB
#define EN_LRUB 1
#endif
#ifndef REP_P0
#define REP_P0 1
#endif
#ifndef REP_P1
#define REP_P1 1
#endif
#ifndef REP_G1
#define REP_G1 1
#endif
#ifndef REP_G3
#define REP_G3 1
#endif
#ifndef REP_ATT
#define REP_ATT 1
#endif
#ifndef REP_LRUA
#define REP_LRUA 1
#endif
#ifndef REP_LRUB
#define REP_LRUB 1
#endif
#ifndef REP_G2
#define REP_G2 1
#endif
#ifndef REP_G4
#define REP_G4 1
#endif
#ifndef EXTRA_SYNCS
#define EXTRA_SYNCS 0
#endif
#ifndef STAG_G2
#define STAG_G2 0
#endif
#ifndef STAG_G4
#define STAG_G4 0
#endif
__device__ __forceinline__ void phase_stagger(int bx, unsigned ticks) {
    if (ticks == 0u) return;
    const unsigned long long t0 = __builtin_amdgcn_s_memrealtime(), dl = (unsigned long long)(((unsigned)bx >> 3) & 3u) * ticks;
    while (__builtin_amdgcn_s_memrealtime() - t0 < dl) __builtin_amdgcn_s_sleep(16);
}
__global__ void __launch_bounds__(512, 2) fwd_megakernel(Args a) {
    extern __shared__ __attribute__((aligned(16))) unsigned char lds_raw[];
    LAS unsigned char* lds = (LAS unsigned char*)lds_raw;
    cg::grid_group grid = cg::this_grid();
    volatile LAS unsigned* bst = (volatile LAS unsigned*)(lds + 151040);
    if (threadIdx.x < 2) bst[threadIdx.x] = 0u;
    __syncthreads();
    const XcdBarrier xbar = xcd_barrier_post((unsigned*)a.ws, bst);
#define GRID_SYNC() xcd_barrier(xbar)
    const int G = gridDim.x, bx = blockIdx.x, NGW = G * 8;
#define PHASE_IDS() const int tid = opaque_tid(), lane = tid & 63, wave = __builtin_amdgcn_readfirstlane(tid >> 6), gw = bx * 8 + wave; (void)lane; (void)gw
    unsigned char* ws = a.ws;
    bf16_t* Wt_in = (bf16_t*)(ws + WS_WIN); bf16_t* Wt_out = (bf16_t*)(ws + WS_WOUT); bf16_t* Wt_fi = (bf16_t*)(ws + WS_WFI); bf16_t* Wt_fo = (bf16_t*)(ws + WS_WFO);
    bf16_t* Wg = (bf16_t*)(ws + WS_WG); float* mod = (float*)(ws + WS_MOD); float* shw1 = (float*)(ws + WS_SHW1); float* shw2 = (float*)(ws + WS_SHW2);
    float* rsq1 = (float*)(ws + WS_RSQ1); float* rsq2 = (float*)(ws + WS_RSQ2); f32x2* agg = (f32x2*)(ws + WS_AGG); float* clamt = (float*)(ws + WS_CLAM);
    bf16_t* hb = (bf16_t*)a.out;
    unsigned short* xh = (unsigned short*)(ws + WS_HB); bf16_t* zb = (bf16_t*)(ws + WS_Z); bf16_t* mix = (bf16_t*)(ws + WS_MIX); bf16_t* hid = (bf16_t*)(ws + WS_HID);

    for (int rep_ = 0; rep_ < REP_P0; ++rep_) {
        PHASE_IDS();
        LAS float* vl = (LAS float*)lds; LAS float* red = (LAS float*)(lds + 81920);
        if (bx < 384) {
            for (int i = tid; i < NB * 1024; i += 512) { const int b = i >> 10, k = i & 1023; const float v = b < 4 ? a.in[2][b * 1024 + k] : a.in[3][(b - 4) * 1024 + k];
                vl[k * NB + b] = v * fsigmoid(v); }
            __syncthreads();
            for (int it = bx; it < 384; it += G) { const int l = it / 96, chk = it % 96;
                gemv20_item(a.in[4] + (size_t)l * DM * NMODC, NMODC, chk * 64, vl, red, mod + (size_t)l * NB * NMODC, NMODC, chk * 64, a.in[5] + (size_t)l * NMODC); }
        }
        __syncthreads();
        LAS float* scr = (LAS float*)(lds + wave * 8448);
        constexpr int I_IN = 16 * 56, I_OUT = 16 * 32, I_FI = 16 * 176, I_FO = 44 * 32, I_L = I_IN + I_OUT + I_FI + I_FO;
        for (int it = gw; it < NLAYER * I_L; it += NGW) { const int l = it / I_L; int r = it % I_L;
            if (r < I_IN) { transpose_item<0>(a.in[7] + (size_t)l * DM * DIN, DM, DIN, Wt_in + (size_t)l * DIN * DM, scr, r, lane); continue; } r -= I_IN;
            if (r < I_OUT) { transpose_item<0>(a.in[18] + (size_t)l * DM * DM, DM, DM, Wt_out + (size_t)l * DM * DM, scr, r, lane); continue; } r -= I_OUT;
            if (r < I_FI) { transpose_item<1>(a.in[20] + (size_t)l * DM * NFI, DM, NFI, Wt_fi + (size_t)l * NFI * DM, scr, r, lane); continue; } r -= I_FI;
            transpose_item<0>(a.in[21] + (size_t)l * DFF * DM, DFF, DM, Wt_fo + (size_t)l * DM * DFF, scr, r, lane); }
        for (int i = bx * 512 + tid; i < NLAYER * 2 * 2 * 8 * 64 * 64; i += G * 512) { const int c = i & 63, m = (i >> 6) & 63, blk = (i >> 12) & 7, gate = (i >> 15) & 1, dir = (i >> 16) & 1, l = i >> 17;
            const float* src = gate ? a.in[13] : a.in[11]; const float v = src[((size_t)((l * 2 + dir) * 8 + blk) * 64 + c) * 64 + m];
            Wg[i] = (bf16_t)(cvt_pk_bf16(v, 0.f) & 0xffffu); }
        for (int i = bx * 512 + tid; i < NLAYER * 1024; i += G * 512) clamt[i] = -8.0f * log1pf(expf(-a.in[15][i])) * LOG2E;
    }
    grid.sync();
    for (int rep_ = 0; rep_ < REP_P1; ++rep_) {
        PHASE_IDS();
        {
            const int grp = bx & 7, l = grp >> 1, which = grp & 1, ldn = which ? NFI : DIN, nitems = ldn / 32;
            const float* src = mod + (size_t)l * NB * NMODC + (which ? 3072 : 0);
            constexpr int SHP = 2064;
            for (int i = tid; i < 32 * 128; i += 512) { const int b = i >> 7, k8 = (i & 127) * 8; u32x4 w = {0u, 0u, 0u, 0u};
                if (b < NB) { const f32x4 v0 = *(const f32x4*)(src + (size_t)b * NMODC + k8), v1 = *(const f32x4*)(src + (size_t)b * NMODC + k8 + 4);
                    w.x = cvt_pk_bf16(v0[0], v0[1]); w.y = cvt_pk_bf16(v0[2], v0[3]); w.z = cvt_pk_bf16(v1[0], v1[1]); w.w = cvt_pk_bf16(v1[2], v1[3]); }
                *(LAS u32x4*)(lds + b * SHP + k8 * 2) = w; }
            __syncthreads();
            const bf16_t* Wt = which ? Wt_fi + (size_t)l * NFI * DM : Wt_in + (size_t)l * DIN * DM; float* dst = which ? shw2 + (size_t)l * NB * NFI : shw1 + (size_t)l * NB * DIN;
            const int r32 = lane & 31, hi = lane >> 5;
            for (int it = (bx >> 3) * 8 + wave; it < nitems; it += 256) {
                f32x16 acc;
#pragma unroll
                for (int r = 0; r < 16; ++r) acc[r] = 0.f;
                const bf16_t* wrow = Wt + (size_t)(it * 32 + r32) * DM + hi * 8;
#pragma unroll 16
                for (int ks = 0; ks < 64; ++ks) { const bf16x8 af = *(LAS const bf16x8*)(lds + r32 * SHP + (16 * ks + 8 * hi) * 2); const bf16x8 bfv = *(const bf16x8*)(wrow + 16 * ks);
                    acc = __builtin_amdgcn_mfma_f32_32x32x16_bf16(af, bfv, acc, 0, 0, 0); }
#pragma unroll
                for (int r = 0; r < 16; ++r) { const int b = crow(r, hi); if (b < NB) dst[(size_t)b * ldn + it * 32 + r32] = acc[r]; }
            }
            __syncthreads();
        }
        for (int row0_ = gw; row0_ < MTOK; row0_ += 2 * NGW) {
            f32x4 v[2][4]; float ssv[2];
#pragma unroll
            for (int rr = 0; rr < 2; ++rr) { const int row = row0_ + rr * NGW; const float* xr = row < 16384 ? a.in[0] + (size_t)row * DM : a.in[1] + (size_t)(row - 16384) * DM;
#pragma unroll
                for (int j = 0; j < 4; ++j) v[rr][j] = ((const f32x4*)xr)[64 * j + lane]; }
#pragma unroll
            for (int rr = 0; rr < 2; ++rr) { float ss = 0.f;
#pragma unroll
                for (int j = 0; j < 4; ++j) ss += (v[rr][j][0] * v[rr][j][0] + v[rr][j][1] * v[rr][j][1]) + (v[rr][j][2] * v[rr][j][2] + v[rr][j][3] * v[rr][j][3]);
                ssv[rr] = wave_sum(ss); }
#pragma unroll
            for (int rr = 0; rr < 2; ++rr) { const int row = row0_ + rr * NGW; const int b = row_batch(row);
#pragma unroll
                for (int j = 0; j < 4; ++j) { const int col = (64 * j + lane) * 4; { typedef _Float16 f16x4 __attribute__((ext_vector_type(4))); *(u32x2*)(xh + (size_t)row * DM + col) = __builtin_bit_cast(u32x2, __builtin_convertvector(v[rr][j], f16x4)); }
                    const f32x4 g4 = *(const f32x4*)(a.in[6] + col), s4 = *(const f32x4*)(mod + (size_t)b * NMODC + 1024 + col); const f32x4 hv = v[rr][j] * g4 * (s4 + 1.0f);
                    u32x2 w2; w2.x = cvt_pk_bf16(hv[0], hv[1]); w2.y = cvt_pk_bf16(hv[2], hv[3]); *(u32x2*)(hb + (size_t)row * DM + col) = w2; }
                if (lane < 16) rsq1[(size_t)lane * MTOK + row] = lane == 0 ? ssv[rr] : 0.f; }
        }
    }
    GRID_SYNC();
#pragma unroll 1
    for (int l = 0; l < NLAYER; ++l) {
        const float* modl = mod + (size_t)l * NB * NMODC;
        for (int rep_ = 0; rep_ < REP_G1; ++rep_) {
            pg8::Gemm g{hb, Wt_in + (size_t)l * DIN * DM, MTOK, DIN, DM}; pg8::StaticOrder S; S.init(MTOK, DIN, G, bx);
            pg8::EpiZ E{zb, DIN, rsq1, shw1 + (size_t)l * NB * DIN, lds};
            pg8::gemm_phase<pg8::EpiZ, pg8::StaticOrder, true, true>(lds, g, S, E);
        }
        GRID_SYNC();
        if (EN_ATT || EN_LRUA) {
            LruP P{a.in[9] + (size_t)l * 4 * 512, a.in[10] + (size_t)l * 512, a.in[12] + (size_t)l * 1024, a.in[14] + (size_t)l * 1024, clamt + (size_t)l * 1024, a.in[17] + (size_t)l * 512, Wg + (size_t)l * 2 * 2 * 8 * 64 * 64};
            for (int u = bx; u < 1536; u += G) { if (u < 768) { for (int rep_ = 0; rep_ < REP_ATT; ++rep_) attn_unit(u, zb, mix, a.in[8] + l * 8, a.in[16] + (size_t)l * 512, lds); } else { for (int rep_ = 0; rep_ < REP_LRUA; ++rep_) lru_unit<false>(u - 768, zb, mix, P, agg, lds); } }
        }
        GRID_SYNC();
        for (int rep_ = 0; rep_ < REP_LRUB; ++rep_) {
            LruP P{a.in[9] + (size_t)l * 4 * 512, a.in[10] + (size_t)l * 512, a.in[12] + (size_t)l * 1024, a.in[14] + (size_t)l * 1024, clamt + (size_t)l * 1024, a.in[17] + (size_t)l * 512, Wg + (size_t)l * 2 * 2 * 8 * 64 * 64};
            for (int u = bx; u < 768; u += G) lru_unit<true>(u, zb, mix, P, agg, lds);
        }
        GRID_SYNC();
        for (int rep_ = 0; rep_ < REP_G2; ++rep_) {
            pg8::Gemm g{mix, Wt_out + (size_t)l * DM * DM, MTOK, DM, DM}; pg8::StaticOrder S; S.init(MTOK, DM, G, bx);
            pg8::EpiRes E{xh, modl + 2048, a.in[19] + (size_t)l * DM, modl + 4096, hb, rsq2, rep_ == REP_G2 - 1 ? 1.0f : 0.0f};
            phase_stagger(bx, STAG_G2);
            pg8::gemm_phase<pg8::EpiRes, pg8::StaticOrder, true, true>(lds, g, S, E);
        }
        GRID_SYNC();
        for (int rep_ = 0; rep_ < REP_G3; ++rep_) {
            pg8::Gemm g{hb, Wt_fi + (size_t)l * NFI * DM, MTOK, NFI, DM}; pg8::StaticOrder S; S.init(MTOK, NFI, G, bx);
            pg8::EpiSwiGLU E{hid, rsq2, shw2 + (size_t)l * NB * NFI, lds};
            pg8::gemm_phase<pg8::EpiSwiGLU, pg8::StaticOrder, true, true>(lds, g, S, E);
        }
        GRID_SYNC();
        for (int rep_ = 0; rep_ < REP_G4; ++rep_) {
            const bool last = (l == NLAYER - 1);
            pg8::Gemm g{hid, Wt_fo + (size_t)l * DM * DFF, MTOK, DM, DFF}; pg8::StaticOrder S; S.init(MTOK, DM, G, bx);
            pg8::EpiRes E{xh, modl + 5120, last ? a.in[6] : a.in[6] + (size_t)(l + 1) * DM, last ? modl + 1024 : modl + (size_t)NB * NMODC + 1024, last ? (bf16_t*)nullptr : hb, rsq1, rep_ == REP_G4 - 1 ? 1.0f : 0.0f};
            phase_stagger(bx, STAG_G4);
            pg8::gemm_phase<pg8::EpiRes, pg8::StaticOrder, true, true>(lds, g, S, E);
        }
        GRID_SYNC();
    }
    for (int e_ = 0; e_ < EXTRA_SYNCS; ++e_) GRID_SYNC();
    PHASE_IDS();
    for (int row0_ = gw; row0_ < MTOK; row0_ += 2 * NGW) {
        typedef _Float16 f16x4 __attribute__((ext_vector_type(4)));
        u32x2 xv[2][4]; float sp[2];
#pragma unroll
        for (int rr = 0; rr < 2; ++rr) { const int row = row0_ + rr * NGW; sp[rr] = lane < 16 ? rsq1[(size_t)lane * MTOK + row] : 0.f;
#pragma unroll
            for (int j = 0; j < 4; ++j) xv[rr][j] = ((const u32x2*)(xh + (size_t)row * DM))[64 * j + lane]; }
#pragma unroll
        for (int rr = 0; rr < 2; ++rr) { const int row = row0_ + rr * NGW; const float rs = rsqrtf(wave_sum(sp[rr]) * (1.0f / DM) + EPS); f32x4* orow = (f32x4*)(a.out + (size_t)row * DM);
#pragma unroll
            for (int j = 0; j < 4; ++j) { const f32x4 v = __builtin_convertvector(__builtin_bit_cast(f16x4, xv[rr][j]), f32x4), g4 = ((const f32x4*)a.in[22])[64 * j + lane]; orow[64 * j + lane] = v * rs * g4; } }
    }
}

extern "C" void kernel_launch(void* const* d_in, const int* in_sizes, int n_in, void* d_out, int out_size, void* d_ws, size_t ws_size, hipStream_t stream) {
    static int grid = 0;
    if (grid == 0) {
        int dev = 0, cus = 0, per_cu = 0;
        (void)hipGetDevice(&dev);
        (void)hipDeviceGetAttribute(&cus, hipDeviceAttributeMultiprocessorCount, dev);
        (void)hipFuncSetAttribute((const void*)fwd_megakernel, hipFuncAttributeMaxDynamicSharedMemorySize, LDS_BYTES);
        (void)hipOccupancyMaxActiveBlocksPerMultiprocessor(&per_cu, (const void*)fwd_megakernel, 512, LDS_BYTES);
        (void)hipGetLastError();
        grid = cus > 0 ? cus : 256;
        if (n_in != 23 || ws_size < WS_END) { fprintf(stderr, "kernel_launch: unexpected n_in %d / ws %zu\n", n_in, ws_size); }
    }
    (void)hipMemsetAsync(d_ws, 0, 16384, stream);
    Args a{};
    for (int i = 0; i < 23; ++i) a.in[i] = (const float*)d_in[i];
    a.out = (float*)d_out; a.ws = (unsigned char*)d_ws;
    void* args[] = {&a};
    hipError_t e = hipLaunchCooperativeKernel((const void*)fwd_megakernel, dim3(grid), dim3(512), args, LDS_BYTES, stream);
    if (e != hipSuccess) fprintf(stderr, "cooperative launch failed: %s (grid %d)\n", hipGetErrorString(e), grid);
}
```

```cpp
#include <hip/hip_runtime.h>
#include <hip/hip_cooperative_groups.h>
#include <cstdio>
#include <cstdint>
namespace cg = cooperative_groups;

constexpr int MTOK = 49152, DM = 1024, DIN = 1792, DFF = 2816, NFI = 5632, NLAYER = 4, NB = 20, NMODC = 6144;
constexpr float EPS = 1e-6f, LOG2E = 1.4426950408889634f;
__device__ __forceinline__ int row_batch(int row) { return row < 16384 ? (row >> 12) : 4 + ((row - 16384) >> 11); }
__device__ __forceinline__ int batch_row0(int b) { return b < 4 ? b * 4096 : 16384 + (b - 4) * 2048; }
__device__ __forceinline__ int batch_len(int b) { return b < 4 ? 4096 : 2048; }
namespace pg8 {
#define PG8_LAS __attribute__((address_space(3)))
typedef unsigned short bf16_t;
typedef short bf16x8 __attribute__((ext_vector_type(8)));
typedef float f32x4 __attribute__((ext_vector_type(4)));
typedef unsigned u32x4 __attribute__((ext_vector_type(4)));
constexpr int BM = 256, BK = 64, HALF = 128, HTB = HALF * BK * 2  , STAGE_BYTES = 8 * HTB, NXCD = 8, WGM = 8;

__host__ __device__ __forceinline__ int lds_byte(int r, int c) { const int st = (r >> 4) * 2 + (c >> 5), rr = r & 15, cc = c & 31, ob = rr * 64 + cc * 2; return st * 1024 + (ob ^ (((ob >> 9) & 1) << 5)); }
__host__ __device__ __forceinline__ void stage_rc(int b, int& R, int& C) { const int st = b / 1024, sb = b % 1024, swz = sb ^ (((sb >> 9) & 1) << 5); R = (st >> 1) * 16 + swz / 64; C = (st & 1) * 32 + (swz % 64) / 2; }
__host__ __device__ __forceinline__ int perm32(int rho) { const int n = rho >> 4, i = rho & 15; return 8 * (i >> 2) + 4 * n + (i & 3); }

struct Unit { int pm, pn; };
struct Gemm { const bf16_t* A; const bf16_t* Bt; int M, N, K; };

struct StaticOrder {
    int nM, nN, nwg, G, c;
    __host__ __device__ void init(int M, int N, int G_, int c_) { nM = M / BM; nN = N / BM; nwg = nM * nN; G = G_; c = c_; }
    __host__ __device__ bool next(int i, Unit& u) const {
        const long L = (long)i * G + c; if (L >= nwg) return false;
        int wgid = (int)L; { const int q = nwg / NXCD, r = nwg % NXCD, xcd = wgid % NXCD, off = wgid / NXCD; wgid = (xcd < r ? xcd * (q + 1) : r * (q + 1) + (xcd - r) * q) + off; }
        const int nig = WGM * nN, gid = wgid / nig, fm = gid * WGM, gsz = (nM - fm) < WGM ? (nM - fm) : WGM;
        u.pm = fm + ((wgid % nig) % gsz); u.pn = (wgid % nig) / gsz; return true;
    }
    __device__ __forceinline__ void a_ready(const Unit&) const {}
    __device__ __forceinline__ void done(const Unit&) const {}
};

__device__ __forceinline__ unsigned cvt_pk_bf16(float lo, float hi) { unsigned r; asm("v_cvt_pk_bf16_f32 %0, %1, %2" : "=v"(r) : "v"(lo), "v"(hi)); return r; }
__device__ __forceinline__ void rows_rstd(const float* rowsq, int row0, int fq, float (&rs)[8]) {
    float part[8][4];
#pragma unroll
    for (int g = 0; g < 8; ++g)
#pragma unroll
        for (int p = 0; p < 4; ++p) part[g][p] = rowsq[(size_t)(fq * 4 + p) * MTOK + row0 + (g >> 2) * HALF + (g & 3) * 16];
    asm volatile("" ::: "memory");
#pragma unroll
    for (int g = 0; g < 8; ++g) { float s = (part[g][0] + part[g][1]) + (part[g][2] + part[g][3]); s += __shfl_xor(s, 16); s += __shfl_xor(s, 32); rs[g] = rsqrtf(s * (1.0f / DM) + EPS); }
}
__device__ __forceinline__ void epi_prefetch(const float* rowsq, const float* biasrow, const Unit& u, PG8_LAS unsigned char* lds, int wid, int lane) {
    const float* g0 = rowsq + (size_t)(lane & 15) * MTOK + u.pm * BM + wid * 32 + (lane >> 4);
#pragma unroll
    for (int i = 0; i < 8; ++i)
        __builtin_amdgcn_global_load_lds((const unsigned*)(g0 + i * 4), (PG8_LAS unsigned*)(lds + 131072 + (wid * 32 + i * 4) * 64), 4, 0, 0);
    __builtin_amdgcn_global_load_lds((const unsigned*)(biasrow + u.pn * BM + (wid & 3) * 64 + lane), (PG8_LAS unsigned*)(lds + 147456 + wid * 256), 4, 0, 0);
}
__device__ __forceinline__ void rows_rstd_lds(PG8_LAS unsigned char* lds, int wr, int fr, int fq, float (&rs)[8]) {
#pragma unroll
    for (int g = 0; g < 8; ++g) { const f32x4 pv = *(const PG8_LAS f32x4*)(lds + 131072 + ((g >> 2) * HALF + wr * 64 + (g & 3) * 16 + fr) * 64 + fq * 16);
        float s = (pv[0] + pv[1]) + (pv[2] + pv[3]); s += __shfl_xor(s, 16); s += __shfl_xor(s, 32); rs[g] = rsqrtf(s * (1.0f / DM) + EPS); }
}
struct EpiZ {
    static constexpr bool PERM = true, AFTER_DRAIN = false;
    static constexpr int NPREF = 0;
    bf16_t* O; int ldc; const float* rowsq; const float* shw; PG8_LAS unsigned char* lds;
    __device__ __forceinline__ void prefetch(const Unit& u, PG8_LAS unsigned char* l_, int wid, int lane) const { epi_prefetch(rowsq, shw + (size_t)row_batch(u.pm * BM) * ldc, u, l_, wid, lane); }
    __device__ __forceinline__ void operator()(const f32x4 (&acc)[2][2][4][2], const Unit& u, int wr, int wc, int fr, int fq) const {
        const int row0 = u.pm * BM + wr * 64 + fr; const int b = row_batch(u.pm * BM);
        const int col0 = u.pn * BM + wc * 32 + 8 * fq;
        f32x4 bv[2][2];
#pragma unroll
        for (int bj = 0; bj < 2; ++bj)
#pragma unroll
            for (int n = 0; n < 2; ++n) bv[bj][n] = *(const f32x4*)(shw + (size_t)b * ldc + col0 + bj * HALF + 4 * n);
        float rsv[8]; rows_rstd(rowsq, row0, fq, rsv);
#pragma unroll
        for (int ai = 0; ai < 2; ++ai)
#pragma unroll
            for (int m = 0; m < 4; ++m) { const int row = row0 + ai * HALF + m * 16; const float rs = rsv[ai * 4 + m];
                bf16_t* rowp = O + (size_t)row * ldc + col0;
#pragma unroll
                for (int bj = 0; bj < 2; ++bj) { const f32x4 v0 = acc[ai][bj][m][0] * rs + bv[bj][0], v1 = acc[ai][bj][m][1] * rs + bv[bj][1];
                    u32x4 w; w.x = cvt_pk_bf16(v0[0], v0[1]); w.y = cvt_pk_bf16(v0[2], v0[3]); w.z = cvt_pk_bf16(v1[0], v1[1]); w.w = cvt_pk_bf16(v1[2], v1[3]);
                    *(u32x4*)(rowp + bj * HALF) = w; } }
    }
};
struct EpiSwiGLU {
    static constexpr bool PERM = true, AFTER_DRAIN = false;
    static constexpr int NPREF = 0;
    bf16_t* O; const float* rowsq; const float* shw; PG8_LAS unsigned char* lds;
    __device__ __forceinline__ void prefetch(const Unit& u, PG8_LAS unsigned char* l_, int wid, int lane) const { epi_prefetch(rowsq, shw + (size_t)row_batch(u.pm * BM) * NFI, u, l_, wid, lane); }
    __device__ __forceinline__ void operator()(const f32x4 (&acc)[2][2][4][2], const Unit& u, int wr, int wc, int fr, int fq) const {
        const int row0 = u.pm * BM + wr * 64 + fr; const int b = row_batch(u.pm * BM);
        const int col0 = u.pn * BM + wc * 32 + 8 * fq, ocol = u.pn * HALF + wc * 32 + 8 * fq;
        f32x4 bv[2][2];
#pragma unroll
        for (int bj = 0; bj < 2; ++bj)
#pragma unroll
            for (int n = 0; n < 2; ++n) bv[bj][n] = *(const f32x4*)(shw + (size_t)b * NFI + col0 + bj * HALF + 4 * n);
        float rsv[8]; rows_rstd(rowsq, row0, fq, rsv);
#pragma unroll
        for (int ai = 0; ai < 2; ++ai)
#pragma unroll
            for (int m = 0; m < 4; ++m) { const int row = row0 + ai * HALF + m * 16; const float rs = rsv[ai * 4 + m];
                float o[8];
#pragma unroll
                for (int n = 0; n < 2; ++n) { const f32x4 g = acc[ai][0][m][n] * rs + bv[0][n], uu = acc[ai][1][m][n] * rs + bv[1][n];
#pragma unroll
                    for (int j = 0; j < 4; ++j) { const float s = __builtin_amdgcn_rcpf(1.0f + __builtin_amdgcn_exp2f(-LOG2E * g[j])); o[4 * n + j] = g[j] * s * uu[j]; } }
                u32x4 w; w.x = cvt_pk_bf16(o[0], o[1]); w.y = cvt_pk_bf16(o[2], o[3]); w.z = cvt_pk_bf16(o[4], o[5]); w.w = cvt_pk_bf16(o[6], o[7]);
                *(u32x4*)(O + (size_t)row * DFF + ocol) = w; }
    }
};
struct EpiRes {
    static constexpr bool PERM = true, AFTER_DRAIN = false;
    static constexpr int NPREF = 0;
    __device__ __forceinline__ void prefetch(const Unit&, PG8_LAS unsigned char*, int, int) const {}
    unsigned short* x; const float* gt; const float* gn; const float* sc; bf16_t* hb; float* rowsq_out; float gsc;
    __device__ __forceinline__ void operator()(const f32x4 (&acc)[2][2][4][2], const Unit& u, int wr, int wc, int fr, int fq) const {
        const int row0 = u.pm * BM + wr * 64 + fr; const int b = row_batch(u.pm * BM);
        const int col0 = u.pn * BM + wc * 32 + 8 * fq;
        f32x4 (&A)[2][2][4][2] = const_cast<f32x4 (&)[2][2][4][2]>(acc);
        typedef _Float16 f16x8 __attribute__((ext_vector_type(8))); typedef float f32x8 __attribute__((ext_vector_type(8)));
        u32x4 xv[3][2]; float ssv[8];
        const unsigned idx0 = (unsigned)row0 * DM + col0;
#define EPR_LOADX(buf, st_) do { const int bj_ = (st_) >> 2, ai_ = ((st_) & 3) >> 1, m0_ = ((st_) & 1) * 2; unsigned ib_ = idx0 + (ai_ * HALF + m0_ * 16) * DM + bj_ * HALF; asm volatile("" : "+v"(ib_)); \
        _Pragma("unroll") for (int mm = 0; mm < 2; ++mm) xv[buf][mm] = *(const u32x4*)(x + (ib_ + mm * 16 * DM)); } while (0)
        EPR_LOADX(0, 0); EPR_LOADX(1, 1);
#pragma unroll
        for (int g = 0; g < 8; ++g) ssv[g] = 0.f;
#pragma unroll
        for (int bj = 0; bj < 2; ++bj)
#pragma unroll
            for (int n = 0; n < 2; ++n) { const f32x4 gv = *(const f32x4*)(gt + (size_t)b * NMODC + col0 + bj * HALF + 4 * n) * gsc;
#pragma unroll
                for (int ai = 0; ai < 2; ++ai)
#pragma unroll
                    for (int m = 0; m < 4; ++m) A[ai][bj][m][n] *= gv; }
        f32x4 mvb[2];
#pragma unroll
        for (int st = 0; st < 8; ++st) { const int bj = st >> 2, ai = (st & 3) >> 1, m0 = (st & 1) * 2, cur = st % 3;
            if ((st & 3) == 0) {
#pragma unroll
                for (int n = 0; n < 2; ++n) { const int c = col0 + bj * HALF + 4 * n;
                    if (hb) { const f32x4 g4 = *(const f32x4*)(gn + c), s4 = *(const f32x4*)(sc + (size_t)b * NMODC + c); mvb[n] = g4 * (s4 + 1.0f); } else mvb[n] = (f32x4){0.f, 0.f, 0.f, 0.f}; }
            }
            if (st + 2 < 8) EPR_LOADX((st + 2) % 3, st + 2);
            asm volatile("" ::: "memory");
            unsigned ib = idx0 + (ai * HALF + m0 * 16) * DM + bj * HALF; asm volatile("" : "+v"(ib));
#pragma unroll
            for (int mm = 0; mm < 2; ++mm) { const int m = m0 + mm; f32x4 xn[2]; float ss = 0.f;
                const f32x8 xf = __builtin_convertvector(__builtin_bit_cast(f16x8, xv[cur][mm]), f32x8);
                xn[0] = (f32x4){xf[0], xf[1], xf[2], xf[3]} + A[ai][bj][m][0]; xn[1] = (f32x4){xf[4], xf[5], xf[6], xf[7]} + A[ai][bj][m][1];
#pragma unroll
                for (int n = 0; n < 2; ++n) ss += (xn[n][0] * xn[n][0] + xn[n][1] * xn[n][1]) + (xn[n][2] * xn[n][2] + xn[n][3] * xn[n][3]);
                { const f32x8 o8 = {xn[0][0], xn[0][1], xn[0][2], xn[0][3], xn[1][0], xn[1][1], xn[1][2], xn[1][3]};
                  *(u32x4*)(x + (ib + mm * 16 * DM)) = __builtin_bit_cast(u32x4, __builtin_convertvector(o8, f16x8)); }
                ssv[ai * 4 + m] += ss;
                if (hb) { const f32x4 h0 = xn[0] * mvb[0], h1 = xn[1] * mvb[1];
                    u32x4 w; w.x = cvt_pk_bf16(h0[0], h0[1]); w.y = cvt_pk_bf16(h0[2], h0[3]); w.z = cvt_pk_bf16(h1[0], h1[1]); w.w = cvt_pk_bf16(h1[2], h1[3]);
                    *(u32x4*)(hb + (ib + mm * 16 * DM)) = w; } }
        }
#undef EPR_LOADX
#pragma unroll
        for (int g = 0; g < 8; ++g) { float ss = ssv[g]; ss += __shfl_xor(ss, 16); ss += __shfl_xor(ss, 32);
            if (fq == 0) rowsq_out[(size_t)(u.pn * 4 + wc) * MTOK + row0 + (g >> 2) * HALF + (g & 3) * 16] = ss; }
    }
};

template <class Epi, class Sched, bool ALIGN_EPI = false, bool SP2 = false>
__device__ __forceinline__ void gemm_phase(PG8_LAS unsigned char* lds, const Gemm g, const Sched& S, const Epi& E) {
    int tid_ = threadIdx.x; asm volatile("" : "+v"(tid_)); const int tid = tid_, wid = __builtin_amdgcn_readfirstlane(tid >> 6), lane = tid & 63, wr = wid >> 2, wc = wid & 3, fr = lane & 15, fq = lane >> 4;
    const int K = g.K, nt = K / BK;
    unsigned voffA[2], voffB[2];
#pragma unroll
    for (int i = 0; i < 2; ++i) { int R, C; stage_rc(tid * 16 + i * 8192, R, C); const int Rb = Epi::PERM ? ((R & ~31) + perm32(R & 31)) : R;
        voffA[i] = (unsigned)(R * K + C) * 2u; voffB[i] = (unsigned)(Rb * K + C) * 2u; }
    const size_t kstep = (size_t)(BK * 2);
    const size_t hstep = (size_t)HALF * K * 2;
    const size_t tstep = 2 * hstep;
    const unsigned ldsw = (unsigned)wid * 1024u;
    const int aoff = lds_byte(wr * 64 + fr, fq * 8), boff = lds_byte(wc * 32 + fr, fq * 8);
#define PG8_SA(b, h) (((b) * 2 + (h)) * HTB)
#define PG8_SB(b, h) ((4 + (b) * 2 + (h)) * HTB)
#define PG8_STAGE(bufoff, gbase, voff) do { _Pragma("unroll") for (int _i = 0; _i < 2; ++_i) \
        __builtin_amdgcn_global_load_lds((const unsigned*)((const char*)(gbase) + (voff)[_i]), (PG8_LAS unsigned*)(lds + (bufoff) + ldsw + _i * 8192), 16, 0, 0); } while (0)
#define PG8_LDA(dst, b, h) do { _Pragma("unroll") for (int m = 0; m < 4; ++m) _Pragma("unroll") for (int k = 0; k < 2; ++k) dst[m][k] = *(const PG8_LAS bf16x8*)(lds + PG8_SA(b, h) + aoff + m * 2048 + k * 1024); } while (0)
#define PG8_LDB(dst, b, h) do { _Pragma("unroll") for (int n = 0; n < 2; ++n) _Pragma("unroll") for (int k = 0; k < 2; ++k) dst[n][k] = *(const PG8_LAS bf16x8*)(lds + PG8_SB(b, h) + boff + n * 2048 + k * 1024); } while (0)
#define PG8_MMA(ai, bj, At, Bt) do { __builtin_amdgcn_s_setprio(1); _Pragma("unroll") for (int m = 0; m < 4; ++m) _Pragma("unroll") for (int n = 0; n < 2; ++n) _Pragma("unroll") for (int k = 0; k < 2; ++k) \
        acc[ai][bj][m][n] = __builtin_amdgcn_mfma_f32_16x16x32_bf16(Bt[n][k], At[m][k], acc[ai][bj][m][n], 0, 0, 0); __builtin_amdgcn_s_setprio(0); } while (0)
#define PG8_WAIT_V(n) asm volatile("s_waitcnt vmcnt(" #n ")" ::: "memory")
#define PG8_WAIT_L(n) asm volatile("s_waitcnt lgkmcnt(" #n ")" ::: "memory")
#define PG8_BAR __builtin_amdgcn_s_barrier()
#define PG8_SCHED __builtin_amdgcn_sched_barrier(0)
    Unit cur, nxt; int ui = 0;
    if (!S.next(0, cur)) return;
    f32x4 acc[2][2][4][2];
#pragma unroll
    for (int a = 0; a < 2; ++a)
#pragma unroll
        for (int b = 0; b < 2; ++b)
#pragma unroll
            for (int m = 0; m < 4; ++m)
#pragma unroll
                for (int n = 0; n < 2; ++n) acc[a][b][m][n] = (f32x4){0.f, 0.f, 0.f, 0.f};
    bf16x8 At[4][2], B0[2][2], B1[2][2];
    const char* cA = (const char*)g.A + (size_t)cur.pm * tstep; const char* cB = (const char*)g.Bt + (size_t)cur.pn * tstep;
    S.a_ready(cur);
    if constexpr (SP2) {
        PG8_STAGE(PG8_SB(0, 0), cB, voffB); PG8_STAGE(PG8_SB(0, 1), cB + hstep, voffB); PG8_STAGE(PG8_SA(0, 0), cA, voffA); PG8_STAGE(PG8_SA(0, 1), cA + hstep, voffA);
        if (wr == 1) PG8_BAR;
        PG8_WAIT_V(2); PG8_BAR;
        PG8_STAGE(PG8_SB(1, 0), cB + kstep, voffB); PG8_STAGE(PG8_SA(1, 0), cA + kstep, voffA); PG8_STAGE(PG8_SB(1, 1), cB + hstep + kstep, voffB);
        PG8_WAIT_V(6); PG8_BAR;
    } else {
        PG8_STAGE(PG8_SB(0, 0), cB, voffB); PG8_STAGE(PG8_SA(0, 0), cA, voffA); PG8_STAGE(PG8_SB(0, 1), cB + hstep, voffB); PG8_STAGE(PG8_SA(0, 1), cA + hstep, voffA);
        if (wr == 1) PG8_BAR;
        PG8_WAIT_V(4); PG8_BAR;
        PG8_STAGE(PG8_SB(1, 0), cB + kstep, voffB); PG8_STAGE(PG8_SA(1, 0), cA + kstep, voffA); PG8_STAGE(PG8_SB(1, 1), cB + hstep + kstep, voffB);
        PG8_WAIT_V(6); PG8_BAR;
    }
    for (;;) {
        const bool has_next = S.next(ui + 1, nxt);
        const char* nA = has_next ? (const char*)g.A + (size_t)nxt.pm * tstep : cA; const char* nB = has_next ? (const char*)g.Bt + (size_t)nxt.pn * tstep : cB;
        for (int t = 0; t < nt; t += 2) {
            const bool last = (t == nt - 2);
            const char* a1 = cA + (size_t)(t + 1) * kstep;
            const char* a2 = last ? nA : cA + (size_t)(t + 2) * kstep; const char* b2 = last ? nB : cB + (size_t)(t + 2) * kstep;
            const char* a3 = a2 + kstep; const char* b3 = b2 + kstep;
            if (last && has_next) S.a_ready(nxt);
            if constexpr (SP2) {
            PG8_LDB(B0, 0, 0); PG8_LDB(B1, 0, 1); PG8_SCHED; PG8_LDA(At, 0, 0); PG8_STAGE(PG8_SA(1, 1), a1 + hstep, voffA);
            PG8_WAIT_V(8); PG8_WAIT_L(0); PG8_BAR; PG8_MMA(0, 0, At, B0); PG8_MMA(0, 1, At, B1); PG8_BAR; PG8_SCHED;
            PG8_LDA(At, 0, 1); PG8_STAGE(PG8_SB(0, 0), b2, voffB); PG8_STAGE(PG8_SB(0, 1), b2 + hstep, voffB); PG8_STAGE(PG8_SA(0, 0), a2, voffA);
            PG8_WAIT_V(8); PG8_WAIT_L(0); PG8_BAR; PG8_MMA(1, 0, At, B0); PG8_MMA(1, 1, At, B1); PG8_BAR; PG8_SCHED;
            PG8_LDB(B0, 1, 0); PG8_LDB(B1, 1, 1); PG8_SCHED; PG8_LDA(At, 1, 0); PG8_STAGE(PG8_SA(0, 1), a2 + hstep, voffA);
            PG8_WAIT_V(8); PG8_WAIT_L(0); PG8_BAR; PG8_MMA(0, 0, At, B0); PG8_MMA(0, 1, At, B1); PG8_BAR; PG8_SCHED;
            PG8_LDA(At, 1, 1); PG8_STAGE(PG8_SB(1, 0), b3, voffB); PG8_STAGE(PG8_SB(1, 1), b3 + hstep, voffB); PG8_STAGE(PG8_SA(1, 0), a3, voffA);
            PG8_WAIT_V(8); PG8_WAIT_L(0); PG8_BAR; PG8_MMA(1, 0, At, B0); PG8_MMA(1, 1, At, B1); PG8_BAR; PG8_SCHED;
            } else {
            PG8_LDB(B0, 0, 0); PG8_SCHED; PG8_LDA(At, 0, 0); PG8_STAGE(PG8_SA(1, 1), a1 + hstep, voffA);
            PG8_WAIT_L(8); PG8_BAR; PG8_WAIT_L(0); PG8_MMA(0, 0, At, B0); PG8_BAR; PG8_SCHED;
            PG8_LDB(B1, 0, 1); PG8_STAGE(PG8_SB(0, 0), b2, voffB);
            PG8_BAR; PG8_WAIT_L(0); PG8_MMA(0, 1, At, B1); PG8_BAR;
            PG8_LDA(At, 0, 1); PG8_STAGE(PG8_SA(0, 0), a2, voffA);
            PG8_BAR; PG8_WAIT_L(0); PG8_MMA(1, 0, At, B0); PG8_BAR; PG8_SCHED;
            PG8_STAGE(PG8_SB(0, 1), b2 + hstep, voffB);
            PG8_WAIT_V(6); PG8_BAR; PG8_MMA(1, 1, At, B1); PG8_BAR;
            PG8_LDB(B0, 1, 0); PG8_SCHED; PG8_LDA(At, 1, 0); PG8_STAGE(PG8_SA(0, 1), a2 + hstep, voffA);
            PG8_WAIT_L(8); PG8_BAR; PG8_WAIT_L(0); PG8_MMA(0, 0, At, B0); PG8_BAR; PG8_SCHED;
            PG8_LDB(B1, 1, 1); PG8_STAGE(PG8_SB(1, 0), b3, voffB);
            PG8_BAR; PG8_WAIT_L(0); PG8_MMA(0, 1, At, B1); PG8_BAR;
            PG8_LDA(At, 1, 1); PG8_STAGE(PG8_SA(1, 0), a3, voffA);
            PG8_BAR; PG8_WAIT_L(0); PG8_MMA(1, 0, At, B0); PG8_BAR; PG8_SCHED;
            PG8_STAGE(PG8_SB(1, 1), b3 + hstep, voffB);
            PG8_WAIT_V(6); PG8_BAR; PG8_MMA(1, 1, At, B1); PG8_BAR;
            }
        }
        if constexpr (ALIGN_EPI) { if (wr == 0) PG8_BAR; }
        if constexpr (!Epi::AFTER_DRAIN) { E(acc, cur, wr, wc, fr, fq); S.done(cur); }
        if (!has_next) break;
#pragma unroll
        for (int a = 0; a < 2; ++a)
#pragma unroll
            for (int b = 0; b < 2; ++b)
#pragma unroll
                for (int m = 0; m < 4; ++m)
#pragma unroll
                    for (int n = 0; n < 2; ++n) acc[a][b][m][n] = (f32x4){0.f, 0.f, 0.f, 0.f};
        cur = nxt; cA = nA; cB = nB; ++ui;
        if constexpr (ALIGN_EPI) { if (wr == 1) PG8_BAR; }
    }
    PG8_WAIT_V(0);
    if constexpr (!ALIGN_EPI) { if (wr == 0) PG8_BAR; }
    PG8_BAR;
    if constexpr (Epi::AFTER_DRAIN) { E.fused(acc, cur, wr, wc, fr, fq, lds, wid, lane); S.done(cur); }
#undef PG8_SA
#undef PG8_SB
#undef PG8_STAGE
#undef PG8_LDA
#undef PG8_LDB
#undef PG8_MMA
#undef PG8_WAIT_V
#undef PG8_WAIT_L
#undef PG8_BAR
#undef PG8_SCHED
}
}

#define LAS __attribute__((address_space(3)))
typedef unsigned short bf16_t;
typedef short bf16x8 __attribute__((ext_vector_type(8)));
typedef float f32x4 __attribute__((ext_vector_type(4)));
typedef float f32x2 __attribute__((ext_vector_type(2)));
typedef float f32x16 __attribute__((ext_vector_type(16)));
typedef unsigned u32x4 __attribute__((ext_vector_type(4)));
typedef unsigned u32x2 __attribute__((ext_vector_type(2)));
#define LDS_WAIT() asm volatile("s_waitcnt lgkmcnt(0)" ::: "memory")
__device__ __forceinline__ int opaque_tid() { int t = threadIdx.x; asm volatile("" : "+v"(t)); return t; }
using pg8::cvt_pk_bf16;
__device__ __forceinline__ float bf2f(unsigned v16) { return __uint_as_float(v16 << 16); }
__device__ __forceinline__ float fexp2(float x) { return __builtin_amdgcn_exp2f(x); }
__device__ __forceinline__ float frcp(float x) { return __builtin_amdgcn_rcpf(x); }
__device__ __forceinline__ float fsigmoid(float x) { return frcp(1.0f + fexp2(-LOG2E * x)); }
__device__ __forceinline__ float wave_sum(float v) {
#pragma unroll
    for (int o = 1; o < 64; o <<= 1) v += __shfl_xor(v, o);
    return v;
}

constexpr size_t MiB = 1u << 20;
constexpr size_t WS_WIN = 1 * MiB, WS_WOUT = 15 * MiB, WS_WFI = 23 * MiB, WS_WFO = 67 * MiB, WS_WG = 89 * MiB, WS_MOD = 90 * MiB, WS_SHW1 = 92 * MiB, WS_SHW2 = 93 * MiB,
                 WS_RSQ1 = 95 * MiB, WS_RSQ2 = 98 * MiB, WS_AGG = 101 * MiB, WS_CLAM = 107 * MiB, WS_HB = 108 * MiB, WS_Z = 204 * MiB, WS_MIX = 372 * MiB, WS_HID = 204 * MiB, WS_END = 468 * MiB;
constexpr int LDS_BYTES = 151552;

struct Args { const float* in[23]; float* out; unsigned char* ws; int pad0, pad1; };

template <int MODE> __device__ __forceinline__ void transpose_item(const float* W, int K, int N, bf16_t* WT, LAS float* scr, int item, int lane) {
    const int nblk = N / 32, kb = item / nblk, nb = item % nblk, k0 = 64 * kb, n0 = 32 * nb;
    float tv[32];
#pragma unroll
    for (int i = 0; i < 32; ++i) tv[i] = W[(size_t)(k0 + 2 * i + (lane >> 5)) * N + n0 + (lane & 31)];
#pragma unroll
    for (int i = 0; i < 32; ++i) scr[(2 * i + (lane >> 5)) * 33 + (lane & 31)] = tv[i];
    LDS_WAIT();
    int drow0 = n0;
    if (MODE == 1) { const int half = n0 >= DFF ? 1 : 0; const int j = n0 - half * DFF; drow0 = (j >> 7) * 256 + half * 128 + (j & 127); }
    const int c = lane & 7;
#pragma unroll
    for (int j = 0; j < 4; ++j) { const int n = (lane >> 3) + 8 * j; const LAS float* s = scr + (8 * c) * 33 + n;
        u32x4 o; o.x = cvt_pk_bf16(s[0 * 33], s[1 * 33]); o.y = cvt_pk_bf16(s[2 * 33], s[3 * 33]); o.z = cvt_pk_bf16(s[4 * 33], s[5 * 33]); o.w = cvt_pk_bf16(s[6 * 33], s[7 * 33]);
        *(u32x4*)(WT + (size_t)(drow0 + n) * K + k0 + 8 * c) = o; }
    LDS_WAIT();
}

__device__ __forceinline__ void gemv20_item(const float* W, int ldw, int srccol0, LAS const float* vl, LAS float* red, float* out, int ostride, int dstcol0, const float* bias) {
    const int tid = opaque_tid(), cl = tid & 63, kg = tid >> 6;
    float acc[NB];
#pragma unroll
    for (int b = 0; b < NB; ++b) acc[b] = 0.f;
    const float* wp = W + (size_t)(kg * 128) * ldw + srccol0 + cl;
    LAS const f32x4* vp = (LAS const f32x4*)(vl + kg * 128 * NB);
#pragma unroll 1
    for (int k0 = 0; k0 < 128; k0 += 32) { float wv[32];
#pragma unroll
        for (int kk = 0; kk < 32; ++kk) wv[kk] = wp[(size_t)(k0 + kk) * ldw];
#pragma unroll
        for (int kk = 0; kk < 32; ++kk) { const float w = wv[kk];
#pragma unroll
            for (int q = 0; q < 5; ++q) { const f32x4 v = vp[(k0 + kk) * 5 + q]; acc[4 * q] += v[0] * w; acc[4 * q + 1] += v[1] * w; acc[4 * q + 2] += v[2] * w; acc[4 * q + 3] += v[3] * w; } } }
#pragma unroll
    for (int b = 0; b < NB; ++b) red[(kg * NB + b) * 64 + cl] = acc[b];
    __syncthreads();
    for (int o = tid; o < NB * 64; o += 512) { const int b = o >> 6, c = o & 63; float s = 0.f;
#pragma unroll
        for (int g = 0; g < 8; ++g) s += red[(g * NB + b) * 64 + c];
        if (bias) s += bias[dstcol0 + c];
        out[(size_t)b * ostride + dstcol0 + c] = s; }
    __syncthreads();
}

constexpr int YPITCH = 1040;
__device__ __forceinline__ void rms_store(LAS const unsigned char* Yl, const float* g, bf16_t* dst) {
    const int tid = opaque_tid(), tok = tid >> 3, sub = tid & 7;
    u32x4 v[8]; float ss = 0.f;
#pragma unroll
    for (int j = 0; j < 8; ++j) { v[j] = *(LAS const u32x4*)(Yl + tok * YPITCH + (j * 8 + sub) * 16);
#pragma unroll
        for (int e = 0; e < 4; ++e) { const float a = bf2f(v[j][e] & 0xffffu), b = __uint_as_float(v[j][e] & 0xffff0000u); ss += a * a + b * b; } }
    ss += __shfl_xor(ss, 1); ss += __shfl_xor(ss, 2); ss += __shfl_xor(ss, 4);
    const float rs = rsqrtf(ss * (1.0f / 512.0f) + EPS);
#pragma unroll
    for (int j = 0; j < 8; ++j) { const int c = (j * 8 + sub) * 8; const f32x4 g0 = *(const f32x4*)(g + c), g1 = *(const f32x4*)(g + c + 4);
        u32x4 o;
        o.x = cvt_pk_bf16(bf2f(v[j][0] & 0xffffu) * rs * g0[0], __uint_as_float(v[j][0] & 0xffff0000u) * rs * g0[1]);
        o.y = cvt_pk_bf16(bf2f(v[j][1] & 0xffffu) * rs * g0[2], __uint_as_float(v[j][1] & 0xffff0000u) * rs * g0[3]);
        o.z = cvt_pk_bf16(bf2f(v[j][2] & 0xffffu) * rs * g1[0], __uint_as_float(v[j][2] & 0xffff0000u) * rs * g1[1]);
        o.w = cvt_pk_bf16(bf2f(v[j][3] & 0xffffu) * rs * g1[2], __uint_as_float(v[j][3] & 0xffff0000u) * rs * g1[3]);
        *(u32x4*)(dst + (size_t)tok * DM + c) = o; }
}

__device__ __forceinline__ int crow(int r, int hi) { return (r & 3) + 8 * (r >> 2) + 4 * hi; }
__device__ __forceinline__ bf16x8 pack8(float a0, float a1, float a2, float a3, float a4, float a5, float a6, float a7) {
    u32x4 w; w.x = cvt_pk_bf16(a0, a1); w.y = cvt_pk_bf16(a2, a3); w.z = cvt_pk_bf16(a4, a5); w.w = cvt_pk_bf16(a6, a7); return __builtin_bit_cast(bf16x8, w);
}

constexpr int KPITCH = 144;
__device__ __forceinline__ void attn_unit(int cgi, const bf16_t* __restrict__ z, bf16_t* mix, const float* sink_l, const float* g_l, LAS unsigned char* lds) {
    const int tid = opaque_tid(), lane = tid & 63, r32 = lane & 31, hi = lane >> 5, h = __builtin_amdgcn_readfirstlane(tid >> 6), kv = h >> 2;
    const int row0 = cgi * 64, b = row_batch(row0), S = batch_len(b), seq0 = batch_row0(b), t0 = row0 - seq0, qb = t0 >> 6, nkb = S >> 6;
    const int kb_lo = qb - 2 < 0 ? 0 : qb - 2, kb_hi = qb + 2 > nkb - 1 ? nkb - 1 : qb + 2;
    LAS unsigned char* Yl = lds + 73728;
    __syncthreads();
#pragma unroll
    for (int qt = 0; qt < 2; ++qt)
#pragma unroll
        for (int d0 = 0; d0 < 4; ++d0) { const u32x4 qv = *(const u32x4*)(z + (size_t)(row0 + 32 * qt + r32) * DIN + h * 64 + d0 * 16 + hi * 8);
            *(LAS u32x4*)(Yl + (32 * qt + r32) * YPITCH + (h * 64 + d0 * 16 + hi * 8) * 2) = qv; }
    LDS_WAIT();
    const float slope2 = fexp2(-(float)(h + 1)) * LOG2E, sc2 = 0.125f * LOG2E;
    float mrun[2], lrun[2]; f32x16 o[2][2];
#pragma unroll
    for (int qt = 0; qt < 2; ++qt) { mrun[qt] = sink_l[h] * LOG2E; lrun[qt] = hi ? 0.f : 1.f;
#pragma unroll
        for (int dh = 0; dh < 2; ++dh)
#pragma unroll
            for (int r = 0; r < 16; ++r) o[qt][dh][r] = 0.f; }
    const int s_key = tid >> 3, s_dch = tid & 7, v_kv = tid >> 8, v_dch = (tid >> 5) & 7, v_pair = tid & 31;
    u32x4 kreg[2], vreg[2];
#define ATT_LOAD(kb) do { const int krow = seq0 + (kb) * 64; \
        _Pragma("unroll") for (int i = 0; i < 2; ++i) { kreg[i] = *(const u32x4*)(z + (size_t)(krow + s_key) * DIN + 512 + i * 64 + s_dch * 8); \
            vreg[i] = *(const u32x4*)(z + (size_t)(krow + 2 * v_pair + i) * DIN + 640 + v_kv * 64 + v_dch * 8); } } while (0)
#define ATT_STORE(bufp) do { LAS unsigned char* Ks_ = (bufp); LAS unsigned char* Vs_ = (bufp) + 18432; \
        _Pragma("unroll") for (int i = 0; i < 2; ++i) *(LAS u32x4*)(Ks_ + (i * 64 + s_key) * KPITCH + s_dch * 16) = kreg[i]; \
        _Pragma("unroll") for (int e = 0; e < 8; ++e) { const unsigned w0 = vreg[0][e >> 1], w1 = vreg[1][e >> 1]; \
            const unsigned lo = (e & 1) ? (w0 >> 16) : (w0 & 0xffffu), hh = (e & 1) ? (w1 & 0xffff0000u) : (w1 << 16); \
            *(LAS unsigned*)(Vs_ + (v_kv * 64 + v_dch * 8 + e) * KPITCH + v_pair * 4) = lo | hh; } } while (0)
    ATT_LOAD(kb_lo);
    ATT_STORE(lds);
    __syncthreads();
    int cur = 0;
    for (int kb = kb_lo; kb <= kb_hi; ++kb) {
        LAS unsigned char* Kl = lds + cur * 36864; LAS unsigned char* Vl = Kl + 18432;
        if (kb < kb_hi) ATT_LOAD(kb + 1);
        const bool edge = (kb - qb == 2) || (qb - kb == 2);
        f32x16 pp[2][2];
#pragma unroll
        for (int qt = 0; qt < 2; ++qt) {
#pragma unroll
            for (int r = 0; r < 16; ++r) { pp[qt][0][r] = 0.f; pp[qt][1][r] = 0.f; }
#pragma unroll
            for (int d0 = 0; d0 < 4; ++d0) {
                const bf16x8 k0f = *(LAS const bf16x8*)(Kl + (kv * 64 + r32) * KPITCH + (16 * d0 + 8 * hi) * 2);
                const bf16x8 k1f = *(LAS const bf16x8*)(Kl + (kv * 64 + 32 + r32) * KPITCH + (16 * d0 + 8 * hi) * 2);
                const bf16x8 qf = *(LAS const bf16x8*)(Yl + (32 * qt + r32) * YPITCH + (h * 64 + d0 * 16 + hi * 8) * 2);
                pp[qt][0] = __builtin_amdgcn_mfma_f32_32x32x16_bf16(k0f, qf, pp[qt][0], 0, 0, 0);
                pp[qt][1] = __builtin_amdgcn_mfma_f32_32x32x16_bf16(k1f, qf, pp[qt][1], 0, 0, 0);
            }
        }
        __builtin_amdgcn_sched_barrier(0);
#pragma unroll
        for (int qt = 0; qt < 2; ++qt) {
            f32x16& p0 = pp[qt][0]; f32x16& p1 = pp[qt][1];
            float dbase = (float)(t0 + 32 * qt + r32 - kb * 64 - 4 * hi); asm volatile("" : "+v"(dbase));
            const float nslope = -slope2, nref = -mrun[qt];
            float bm = -1e30f;
#pragma unroll
            for (int r = 0; r < 16; ++r) { const float d_0 = dbase - (float)((r & 3) + 8 * (r >> 2)), d_1 = dbase - (float)((r & 3) + 8 * (r >> 2) + 32); float t0_, t1_;
                asm("v_fma_f32 %0, |%1|, %2, %3" : "=v"(t0_) : "v"(d_0), "v"(nslope), "v"(nref));
                asm("v_fma_f32 %0, |%1|, %2, %3" : "=v"(t1_) : "v"(d_1), "v"(nslope), "v"(nref));
                p0[r] = __builtin_fmaf(p0[r], sc2, t0_); p1[r] = __builtin_fmaf(p1[r], sc2, t1_); }
            if (edge) {
#pragma unroll
                for (int r = 0; r < 16; ++r) { const float d_0 = dbase - (float)((r & 3) + 8 * (r >> 2)), d_1 = dbase - (float)((r & 3) + 8 * (r >> 2) + 32);
                    p0[r] = __builtin_fabsf(d_0) <= 128.0f ? p0[r] : -1e30f; p1[r] = __builtin_fabsf(d_1) <= 128.0f ? p1[r] : -1e30f; }
            }
#pragma unroll
            for (int r = 0; r < 16; ++r) bm = fmaxf(bm, fmaxf(p0[r], p1[r]));
            bm = fmaxf(bm, __shfl_xor(bm, 32));
            if (__any(bm > 0.f)) {
                const float dl = fmaxf(bm, 0.f), alpha = fexp2(-dl); mrun[qt] += dl; lrun[qt] *= alpha;
#pragma unroll
                for (int r = 0; r < 16; ++r) { p0[r] -= dl; p1[r] -= dl; }
#pragma unroll
                for (int dh = 0; dh < 2; ++dh)
#pragma unroll
                    for (int r = 0; r < 16; ++r) o[qt][dh][r] *= alpha;
            }
            { float ls = 0.f;
#pragma unroll
              for (int r = 0; r < 16; ++r) { p0[r] = fexp2(p0[r]); p1[r] = fexp2(p1[r]); ls += p0[r] + p1[r]; }
              lrun[qt] += ls; }
            __builtin_amdgcn_sched_barrier(0);
            bf16x8 pf[4];
            pf[0] = pack8(p0[0], p0[1], p0[2], p0[3], p0[4], p0[5], p0[6], p0[7]); pf[1] = pack8(p0[8], p0[9], p0[10], p0[11], p0[12], p0[13], p0[14], p0[15]);
            pf[2] = pack8(p1[0], p1[1], p1[2], p1[3], p1[4], p1[5], p1[6], p1[7]); pf[3] = pack8(p1[8], p1[9], p1[10], p1[11], p1[12], p1[13], p1[14], p1[15]);
#pragma unroll
            for (int ks = 0; ks < 4; ++ks)
#pragma unroll
                for (int dh = 0; dh < 2; ++dh) {
                    LAS const unsigned char* vp = Vl + (kv * 64 + 32 * dh + r32) * KPITCH + (16 * ks + 4 * hi) * 2;
                    const u32x2 a = *(LAS const u32x2*)vp, c = *(LAS const u32x2*)(vp + 16);
                    const u32x4 vv = {a.x, a.y, c.x, c.y};
                    o[qt][dh] = __builtin_amdgcn_mfma_f32_32x32x16_bf16(__builtin_bit_cast(bf16x8, vv), pf[ks], o[qt][dh], 0, 0, 0);
                }
        }
        if (kb < kb_hi) ATT_STORE(lds + (cur ^ 1) * 36864);
        __syncthreads();
        cur ^= 1;
    }
#undef ATT_LOAD
#undef ATT_STORE
    LDS_WAIT();
#pragma unroll
    for (int qt = 0; qt < 2; ++qt) { const float lt = lrun[qt] + __shfl_xor(lrun[qt], 32), inv = 1.0f / lt;
#pragma unroll
        for (int dh = 0; dh < 2; ++dh)
#pragma unroll
            for (int r4 = 0; r4 < 4; ++r4) { u32x2 w; w.x = cvt_pk_bf16(o[qt][dh][4 * r4] * inv, o[qt][dh][4 * r4 + 1] * inv); w.y = cvt_pk_bf16(o[qt][dh][4 * r4 + 2] * inv, o[qt][dh][4 * r4 + 3] * inv);
                *(LAS u32x2*)(Yl + (32 * qt + r32) * YPITCH + (h * 64 + 32 * dh + 8 * r4 + 4 * hi) * 2) = w; } }
    __syncthreads();
    rms_store(Yl, g_l, mix + (size_t)row0 * DM);
    __syncthreads();
}


constexpr int AW_BYTES = 26624, AW_K = 0, AW_V = 4608, AW_Q = 9728, VPITCH = 80, QPITCH = 528;
__device__ __forceinline__ void attn_wave(int cgi, int j, const bf16_t* __restrict__ z, bf16_t* mix, float* asq, const float* sink_l, LAS unsigned char* lds) {
    const int lane = opaque_tid() & 63, r32 = lane & 31, hi = lane >> 5, kvg = j >> 1, qt = j & 1;
    const int row0 = cgi * 64, b = row_batch(row0), S = batch_len(b), seq0 = batch_row0(b), tq0 = row0 - seq0 + 32 * qt, qb32 = tq0 >> 5, nkb = S >> 5;
    const int kb_lo = qb32 - 4 < 0 ? 0 : qb32 - 4, kb_hi = qb32 + 4 > nkb - 1 ? nkb - 1 : qb32 + 4;
    LAS unsigned char* Kl = lds + j * AW_BYTES + AW_K; LAS unsigned char* Vl = lds + j * AW_BYTES + AW_V; LAS unsigned char* Ql = lds + j * AW_BYTES + AW_Q;
    u32x4 kreg[4], vreg[2][2];
    const int vp = lane & 15, vd = lane >> 4;
#define AW_LOAD(kb) do { const bf16_t* zr_ = z + (size_t)(seq0 + (kb) * 32) * DIN + 512 + kvg * 64; \
        _Pragma("unroll") for (int i = 0; i < 4; ++i) { const int c_ = i * 64 + lane; kreg[i] = *(const u32x4*)(zr_ + (size_t)(c_ >> 3) * DIN + (c_ & 7) * 8); } \
        _Pragma("unroll") for (int i = 0; i < 2; ++i) _Pragma("unroll") for (int e2 = 0; e2 < 2; ++e2) vreg[i][e2] = *(const u32x4*)(zr_ + (size_t)(2 * vp + e2) * DIN + 128 + (vd + 4 * i) * 8); } while (0)
#define AW_STORE() do { _Pragma("unroll") for (int i = 0; i < 4; ++i) { const int c_ = i * 64 + lane; *(LAS u32x4*)(Kl + (c_ >> 3) * KPITCH + (c_ & 7) * 16) = kreg[i]; } \
        _Pragma("unroll") for (int i = 0; i < 2; ++i) _Pragma("unroll") for (int e = 0; e < 8; ++e) { const unsigned w0 = vreg[i][0][e >> 1], w1 = vreg[i][1][e >> 1]; \
            const unsigned lo = (e & 1) ? (w0 >> 16) : (w0 & 0xffffu), hh = (e & 1) ? (w1 & 0xffff0000u) : (w1 << 16); \
            *(LAS unsigned*)(Vl + ((vd + 4 * i) * 8 + e) * VPITCH + vp * 4) = lo | hh; } } while (0)
#pragma unroll
    for (int h4 = 0; h4 < 4; ++h4)
#pragma unroll
        for (int d0 = 0; d0 < 4; ++d0) { const u32x4 qv = *(const u32x4*)(z + (size_t)(row0 + 32 * qt + r32) * DIN + (kvg * 4 + h4) * 64 + d0 * 16 + hi * 8);
            *(LAS u32x4*)(Ql + r32 * QPITCH + h4 * 128 + (d0 * 16 + hi * 8) * 2) = qv; }
    const float sc2 = 0.125f * LOG2E;
    float mrun[4], lrun[4]; f32x16 o[4][2];
#pragma unroll
    for (int h4 = 0; h4 < 4; ++h4) { mrun[h4] = sink_l[kvg * 4 + h4] * LOG2E; lrun[h4] = hi ? 0.f : 1.f;
#pragma unroll
        for (int dh = 0; dh < 2; ++dh)
#pragma unroll
            for (int r = 0; r < 16; ++r) o[h4][dh][r] = 0.f; }
    for (int kb = kb_lo; kb <= kb_hi; ++kb) {
        AW_LOAD(kb);
        LDS_WAIT();
        AW_STORE();
        LDS_WAIT();
        const bool edge = (kb - qb32 == 4) || (qb32 - kb == 4);
        const float dbase0 = (float)(tq0 + r32 - kb * 32 - 4 * hi);
#pragma unroll
        for (int h4 = 0; h4 < 4; ++h4) {
            __builtin_amdgcn_sched_barrier(0);
            float dbase = dbase0; asm volatile("" : "+v"(dbase));
            f32x16 p;
#pragma unroll
            for (int r = 0; r < 16; ++r) p[r] = 0.f;
#pragma unroll
            for (int d0 = 0; d0 < 4; ++d0) {
                const bf16x8 kf = *(LAS const bf16x8*)(Kl + r32 * KPITCH + (16 * d0 + 8 * hi) * 2);
                const bf16x8 qf = *(LAS const bf16x8*)(Ql + r32 * QPITCH + h4 * 128 + (d0 * 16 + hi * 8) * 2);
                p = __builtin_amdgcn_mfma_f32_32x32x16_bf16(kf, qf, p, 0, 0, 0);
            }
            const float nslope = -fexp2(-(float)(kvg * 4 + h4 + 1)) * LOG2E, nref = -mrun[h4];
            float bm = -1e30f;
#pragma unroll
            for (int r = 0; r < 16; ++r) { const float d_0 = dbase - (float)((r & 3) + 8 * (r >> 2)); float t0_;
                asm("v_fma_f32 %0, |%1|, %2, %3" : "=v"(t0_) : "v"(d_0), "v"(nslope), "v"(nref));
                p[r] = __builtin_fmaf(p[r], sc2, t0_); }
            if (edge) {
#pragma unroll
                for (int r = 0; r < 16; ++r) { const float d_0 = dbase - (float)((r & 3) + 8 * (r >> 2)); p[r] = __builtin_fabsf(d_0) <= 128.0f ? p[r] : -1e30f; }
            }
#pragma unroll
            for (int r = 0; r < 16; ++r) bm = fmaxf(bm, p[r]);
            bm = fmaxf(bm, __shfl_xor(bm, 32));
            if (__any(bm > 0.f)) {
                const float dl = fmaxf(bm, 0.f), alpha = fexp2(-dl); mrun[h4] += dl; lrun[h4] *= alpha;
#pragma unroll
                for (int r = 0; r < 16; ++r) p[r] -= dl;
#pragma unroll
                for (int dh = 0; dh < 2; ++dh)
#pragma unroll
                    for (int r = 0; r < 16; ++r) o[h4][dh][r] *= alpha;
            }
            { float ls = 0.f;
#pragma unroll
              for (int r = 0; r < 16; ++r) { p[r] = fexp2(p[r]); ls += p[r]; }
              lrun[h4] += ls; }
            bf16x8 pf[2];
            pf[0] = pack8(p[0], p[1], p[2], p[3], p[4], p[5], p[6], p[7]); pf[1] = pack8(p[8], p[9], p[10], p[11], p[12], p[13], p[14], p[15]);
#pragma unroll
            for (int ks = 0; ks < 2; ++ks)
#pragma unroll
                for (int dh = 0; dh < 2; ++dh) {
                    LAS const unsigned char* vq = Vl + (32 * dh + r32) * VPITCH + (16 * ks + 4 * hi) * 2;
                    const u32x2 a_ = *(LAS const u32x2*)vq, c_ = *(LAS const u32x2*)(vq + 16);
                    const u32x4 vv = {a_.x, a_.y, c_.x, c_.y};
                    o[h4][dh] = __builtin_amdgcn_mfma_f32_32x32x16_bf16(__builtin_bit_cast(bf16x8, vv), pf[ks], o[h4][dh], 0, 0, 0);
                }
        }
    }
#undef AW_LOAD
#undef AW_STORE
    float ssq = 0.f; const int row = row0 + 32 * qt + r32;
#pragma unroll
    for (int h4 = 0; h4 < 4; ++h4) { const float lt = lrun[h4] + __shfl_xor(lrun[h4], 32), inv = 1.0f / lt;
#pragma unroll
        for (int dh = 0; dh < 2; ++dh)
#pragma unroll
            for (int r4 = 0; r4 < 4; ++r4) { const float v0 = o[h4][dh][4 * r4] * inv, v1 = o[h4][dh][4 * r4 + 1] * inv, v2 = o[h4][dh][4 * r4 + 2] * inv, v3 = o[h4][dh][4 * r4 + 3] * inv;
                ssq += (v0 * v0 + v1 * v1) + (v2 * v2 + v3 * v3);
                u32x2 w; w.x = cvt_pk_bf16(v0, v1); w.y = cvt_pk_bf16(v2, v3);
                *(u32x2*)(mix + (size_t)row * DM + (kvg * 4 + h4) * 64 + 32 * dh + 8 * r4 + 4 * hi) = w; } }
    ssq += __shfl_xor(ssq, 32);
    if (hi == 0) asq[(size_t)row * 2 + kvg] = ssq;
    LDS_WAIT();
}
__device__ __forceinline__ void attn_norm_rows(bf16_t* mixrow0, const float* asq_row0, const float* g) {
    const int tid = opaque_tid(), tok = tid >> 3, sub = tid & 7;
    const float rs = rsqrtf((asq_row0[tok * 2] + asq_row0[tok * 2 + 1]) * (1.0f / 512.0f) + EPS);
    u32x4 v[8];
#pragma unroll
    for (int jj = 0; jj < 8; ++jj) v[jj] = *(const u32x4*)(mixrow0 + (size_t)tok * DM + (jj * 8 + sub) * 8);
#pragma unroll
    for (int jj = 0; jj < 8; ++jj) { const int c = (jj * 8 + sub) * 8; const f32x4 g0 = *(const f32x4*)(g + c), g1 = *(const f32x4*)(g + c + 4);
        u32x4 o_;
        o_.x = cvt_pk_bf16(bf2f(v[jj][0] & 0xffffu) * rs * g0[0], __uint_as_float(v[jj][0] & 0xffff0000u) * rs * g0[1]);
        o_.y = cvt_pk_bf16(bf2f(v[jj][1] & 0xffffu) * rs * g0[2], __uint_as_float(v[jj][1] & 0xffff0000u) * rs * g0[3]);
        o_.z = cvt_pk_bf16(bf2f(v[jj][2] & 0xffffu) * rs * g1[0], __uint_as_float(v[jj][2] & 0xffff0000u) * rs * g1[1]);
        o_.w = cvt_pk_bf16(bf2f(v[jj][3] & 0xffffu) * rs * g1[2], __uint_as_float(v[jj][3] & 0xffff0000u) * rs * g1[3]);
        *(u32x4*)(mixrow0 + (size_t)tok * DM + c) = o_; }
}

struct LruP { const float *conv_w, *conv_b, *b_rg, *b_ig, *lam, *g_lru; const bf16_t* wg; };
template <int DIR> __device__ __forceinline__ void scan32(const f32x16& A, const f32x16& U, float& c, float& Atot, int hi, float (&hsv)[16]) {
    float Ag[4], Hg[4], oA[4], oH[4], cin[4];
#pragma unroll
    for (int gi = 0; gi < 4; ++gi) { const float a0 = A[4 * gi], a1 = A[4 * gi + 1], a2 = A[4 * gi + 2], a3 = A[4 * gi + 3], u0 = U[4 * gi], u1 = U[4 * gi + 1], u2 = U[4 * gi + 2], u3 = U[4 * gi + 3];
        Ag[gi] = (a0 * a1) * (a2 * a3); float hh;
        if (DIR == 0) { hh = u0; hh = a1 * hh + u1; hh = a2 * hh + u2; hh = a3 * hh + u3; } else { hh = u3; hh = a2 * hh + u2; hh = a1 * hh + u1; hh = a0 * hh + u0; }
        Hg[gi] = hh; oA[gi] = __shfl_xor(Ag[gi], 32); oH[gi] = __shfl_xor(hh, 32); }
#pragma unroll
    for (int g_ = 0; g_ < 4; ++g_) { const int gi = DIR == 0 ? g_ : 3 - g_;
        const float AE = hi ? oA[gi] : Ag[gi], HE = hi ? oH[gi] : Hg[gi], AO = hi ? Ag[gi] : oA[gi], HO = hi ? Hg[gi] : oH[gi];
        float ce, co;
        if (DIR == 0) { ce = c; c = AE * c + HE; co = c; c = AO * c + HO; } else { co = c; c = AO * c + HO; ce = c; c = AE * c + HE; }
        cin[gi] = hi ? co : ce; Atot *= AE * AO; }
#pragma unroll
    for (int gi = 0; gi < 4; ++gi) { float hh = cin[gi];
#pragma unroll
        for (int j_ = 0; j_ < 4; ++j_) { const int j = DIR == 0 ? j_ : 3 - j_; hh = A[4 * gi + j] * hh + U[4 * gi + j]; hsv[4 * gi + j] += hh; } }
}
template <bool FINAL> __device__ __forceinline__ void lru_unit(int cgi, int w, LAS unsigned char* XC, const bf16_t* __restrict__ z, bf16_t* mix, const LruP P, f32x2* agg, LAS unsigned char* lds) {
    const int tid = opaque_tid(), lane = tid & 63, r32 = lane & 31, hi = lane >> 5, c0 = 64 * w;
    const int row0 = cgi * 64, b = row_batch(row0), S = batch_len(b), seq0 = batch_row0(b), t0 = row0 - seq0, ch = t0 >> 6, nch = S >> 6, chunkbase = cgi - ch;
    LAS unsigned char* Yl = lds + 77184;
    LAS float* CAR = (LAS float*)(lds + 143744) + w * 128;
    u32x4 raw[9];
#pragma unroll
    for (int i = 0; i < 9; ++i) { const int idx = i * 64 + lane, t = idx >> 3, chunk = idx & 7, tok = t0 - 2 + t;
        raw[i] = (u32x4){0u, 0u, 0u, 0u};
        if (t < 67 && tok >= 0 && tok < S) raw[i] = *(const u32x4*)(z + (size_t)(seq0 + tok) * DIN + 768 + c0 + chunk * 8); }
    if (FINAL) {
        u32x4 graw[8];
#pragma unroll
        for (int i = 0; i < 8; ++i) { const int idx = i * 64 + lane, t = idx >> 3, chunk = idx & 7; graw[i] = *(const u32x4*)(z + (size_t)(row0 + t) * DIN + 1280 + c0 + chunk * 8); }
#pragma unroll
        for (int i = 0; i < 8; ++i) { const int idx = i * 64 + lane, t = idx >> 3, chunk = idx & 7; *(LAS u32x4*)(Yl + t * YPITCH + (c0 + chunk * 8) * 2) = graw[i]; }
    }
    const int cc = c0 + lane; const float cb = P.conv_b[cc], w0 = P.conv_w[cc], w1 = P.conv_w[512 + cc], w2 = P.conv_w[1024 + cc], w3 = P.conv_w[1536 + cc];
    bf16x8 wf[2][8]; float bb[2][3];
#define LRU_LOADW(buf, mt_, dir_) do { const bf16_t* wp_ = P.wg + ((size_t)(((dir_) * 2) * 8 + w) * 64 + 32 * (mt_) + r32) * 64 + hi * 8; \
        _Pragma("unroll") for (int ks = 0; ks < 4; ++ks) { wf[buf][ks] = *(const bf16x8*)(wp_ + ks * 16); wf[buf][4 + ks] = *(const bf16x8*)(wp_ + 8 * 64 * 64 + ks * 16); } \
        const int chn_ = c0 + 32 * (mt_) + r32; bb[buf][0] = P.b_rg[(dir_) * 512 + chn_]; bb[buf][1] = P.b_ig[(dir_) * 512 + chn_]; bb[buf][2] = P.lam[(dir_) * 512 + chn_]; } while (0)
    LRU_LOADW(0, 0, 0);
    if (FINAL) {
        float cf = 0.f, cbk = 0.f;
        const f32x2* ap = agg + (size_t)chunkbase * 1024 + cc;
#pragma unroll 8
        for (int j = 0; j < ch; ++j) { const f32x2 ah = ap[(size_t)j * 1024]; cf = ah.x * cf + ah.y; }
#pragma unroll 8
        for (int j = nch - 1; j > ch; --j) { const f32x2 ah = ap[(size_t)j * 1024 + 512]; cbk = ah.x * cbk + ah.y; }
        CAR[lane] = cf; CAR[64 + lane] = cbk;
    }
#pragma unroll
    for (int i = 0; i < 9; ++i) { const int idx = i * 64 + lane, t = idx >> 3, chunk = idx & 7; if (t < 67) *(LAS u32x4*)(XC + t * KPITCH + chunk * 16) = raw[i]; }
    LDS_WAIT();
    {
#define XLD(r) bf2f(*(LAS const unsigned short*)(XC + (r) * KPITCH + lane * 2))
        float a0 = XLD(0), a1 = XLD(1), a2 = XLD(2);
#pragma unroll 16
        for (int t = 0; t < 64; ++t) { const float a3 = XLD(t + 3); const float xc = cb + w0 * a0 + w1 * a1 + w2 * a2 + w3 * a3;
            *(LAS unsigned short*)(XC + t * KPITCH + lane * 2) = (unsigned short)(cvt_pk_bf16(xc, 0.f) & 0xffffu); a0 = a1; a1 = a2; a2 = a3; }
#undef XLD
        LDS_WAIT();
    }
#pragma unroll
    for (int mt = 0; mt < 2; ++mt) {
        const int chn = c0 + 32 * mt + r32;
        float hs[2][16];
#pragma unroll
        for (int s = 0; s < 2; ++s)
#pragma unroll
            for (int r = 0; r < 16; ++r) hs[s][r] = 0.f;
#pragma unroll
        for (int dir = 0; dir < 2; ++dir) {
            const int step = 2 * mt + dir, cur = step & 1;
            if (step < 3) LRU_LOADW(cur ^ 1, (step + 1) >> 1, (step + 1) & 1);
            __builtin_amdgcn_sched_barrier(0);
            const float brg = -LOG2E * bb[cur][0], big = -LOG2E * bb[cur][1], clam = bb[cur][2];
            float c = 0.f, Atot = 1.f;
            if (FINAL) c = CAR[dir * 64 + 32 * mt + r32];
#pragma unroll
            for (int si = 0; si < 2; ++si) { const int s = dir ? 1 - si : si;
                __builtin_amdgcn_sched_barrier(0);
                f32x16 accr, acci;
#pragma unroll
                for (int r = 0; r < 16; ++r) { accr[r] = 0.f; acci[r] = 0.f; }
#pragma unroll
                for (int ks = 0; ks < 4; ++ks) { const bf16x8 af = *(LAS const bf16x8*)(XC + (32 * s + r32) * KPITCH + (16 * ks + 8 * hi) * 2);
                    accr = __builtin_amdgcn_mfma_f32_32x32x16_bf16(af, wf[cur][ks], accr, 0, 0, 0); acci = __builtin_amdgcn_mfma_f32_32x32x16_bf16(af, wf[cur][4 + ks], acci, 0, 0, 0); }
#pragma unroll
                for (int r = 0; r < 16; ++r) { const float xv = bf2f(*(LAS const unsigned short*)(XC + (32 * s + crow(r, hi)) * KPITCH + (32 * mt + r32) * 2));
                    const float rr = frcp(1.0f + fexp2(__builtin_fmaf(accr[r], -LOG2E, brg))), ii = frcp(1.0f + fexp2(__builtin_fmaf(acci[r], -LOG2E, big))), a = fexp2(rr * clam);
                    accr[r] = a; acci[r] = __builtin_amdgcn_sqrtf(fmaxf(1.0f - a * a, 0.f)) * ii * xv; }
                if (dir == 0) scan32<0>(accr, acci, c, Atot, hi, hs[s]); else scan32<1>(accr, acci, c, Atot, hi, hs[s]);
            }
            if (!FINAL) { if (hi == 0) agg[((size_t)cgi * 2 + dir) * 512 + chn] = (f32x2){Atot, c}; }
        }
        if (FINAL) {
#pragma unroll
            for (int s = 0; s < 2; ++s) { __builtin_amdgcn_sched_barrier(0);
#pragma unroll
                for (int r = 0; r < 16; ++r) { const int t = 32 * s + crow(r, hi); const float gte = bf2f(*(LAS const unsigned short*)(Yl + t * YPITCH + chn * 2));
                    const float ge = gte * frcp(1.0f + fexp2(-LOG2E * 1.5957691216f * (gte + 0.044715f * gte * gte * gte)));
                    *(LAS unsigned short*)(Yl + t * YPITCH + chn * 2) = (unsigned short)(cvt_pk_bf16(hs[s][r] * ge, 0.f) & 0xffffu); } }
        }
    }
#undef LRU_LOADW
    if (FINAL) {
        __syncthreads();
        rms_store(Yl, P.g_lru, mix + (size_t)row0 * DM + 512);
        __syncthreads();
    }
}

#define RLX_AGENT __ATOMIC_RELAXED, __HIP_MEMORY_SCOPE_AGENT
#define XB_TMO      128
#define XB_XCNT(j)  (256  + 64 * (j))
#define XB_XSUB(j)  (1280 + 64 * (j))
#define XB_XGEN(j)  (2304 + 64 * (j))
#define XB_TOP      3328
#define XB_TOPGEN   3392
#define XCD_BAR_WORDS 3456
#define XB_SPIN_CAP (1u << 18)

__device__ __forceinline__ unsigned xb_ld(unsigned* p)              { return __hip_atomic_load(p, __ATOMIC_RELAXED, __HIP_MEMORY_SCOPE_AGENT); }
__device__ __forceinline__ unsigned xb_add(unsigned* p, unsigned v) { return __hip_atomic_fetch_add(p, v, __ATOMIC_RELAXED, __HIP_MEMORY_SCOPE_AGENT); }
__device__ __forceinline__ unsigned xb_xcc_id() { return (unsigned)__builtin_amdgcn_s_getreg((3 << 11) | 20) & 0xFu; }
#define XB_SPIN(cond, bar) do { unsigned _sp = 0; while (cond) { __builtin_amdgcn_s_sleep(1); \
    if ((++_sp & 255u) == 0u) { if (xb_ld(&(bar)[XB_TMO])) break; if (_sp > XB_SPIN_CAP) { atomicAdd(&(bar)[XB_TMO], 1u); break; } } } } while (0)

struct XcdBarrier {
    unsigned* bar; unsigned x;
    volatile LAS unsigned* st;
};

__device__ __forceinline__ XcdBarrier xcd_barrier_post(unsigned* bar, volatile LAS unsigned* st) {
    XcdBarrier b; b.bar = bar; b.x = xb_xcc_id(); b.st = st;
    if (threadIdx.x == 0) (void)xb_add(&bar[XB_XCNT(b.x)], 1u);
    return b;
}
__device__ __forceinline__ void xcd_barrier_complete(unsigned* bar, unsigned x, unsigned& nloc, unsigned& nx) {
    const unsigned G = gridDim.x * gridDim.y * gridDim.z;
    unsigned sum, cnt, mine, sp = 0u;
    for (;;) {
        sum = 0u; cnt = 0u; mine = 0u;
#pragma unroll
        for (unsigned j = 0; j < 16; ++j) { const unsigned c = xb_ld(&bar[XB_XCNT(j)]); sum += c; cnt += (c > 0u) ? 1u : 0u; mine = (j == x) ? c : mine; }
        if (sum == G) break;
        __builtin_amdgcn_s_sleep(1);
        if ((++sp & 255u) == 0u) { if (xb_ld(&bar[XB_TMO])) break; if (sp > XB_SPIN_CAP) { atomicAdd(&bar[XB_TMO], 1u); break; } }
    }
    nloc = mine > 0u ? mine : 1u; nx = cnt > 0u ? cnt : 1u;
}

__device__ __forceinline__ void xcd_barrier(const XcdBarrier& b) {
    asm volatile("s_waitcnt vmcnt(0)" ::: "memory");
    __syncthreads();
    if (threadIdx.x == 0) {
        unsigned* bar = b.bar; const unsigned bx_ = xb_xcc_id();
        __builtin_amdgcn_s_waitcnt(0);
        unsigned nloc = b.st[0], nx = b.st[1];
        if (nloc == 0u) { xcd_barrier_complete(bar, bx_, nloc, nx); b.st[0] = nloc; b.st[1] = nx; }
        const unsigned old = xb_add(&bar[XB_XSUB(bx_)], 1u);
        const unsigned gen = old / nloc;
        if (old + 1u == (gen + 1u) * nloc) {
            __builtin_amdgcn_fence(__ATOMIC_RELEASE, "agent");
            asm volatile("s_waitcnt vmcnt(0)" ::: "memory");
            const unsigned og = xb_add(&bar[XB_TOP], 1u);
            const unsigned tg = og / nx;
            if (og + 1u == (tg + 1u) * nx) xb_add(&bar[XB_TOPGEN], 1u);
            else XB_SPIN(xb_ld(&bar[XB_TOPGEN]) == tg, bar);
            __builtin_amdgcn_fence(__ATOMIC_ACQUIRE, "agent");
            xb_add(&bar[XB_XGEN(bx_)], 1u);
            asm volatile("s_waitcnt vmcnt(0)" ::: "memory");
        } else {
            XB_SPIN(xb_ld(&bar[XB_XGEN(bx_)]) == gen, bar);
            __builtin_amdgcn_fence(__ATOMIC_ACQUIRE, "agent");
            asm volatile("s_waitcnt vmcnt(0)" ::: "memory");
        }
    }
    __syncthreads();
}

#ifndef EN_P0
#define EN_P0 1
#endif
#ifndef EN_P1
#define EN_P1 1
#endif
#ifndef EN_G1
#define EN_G1 1
#endif
#ifndef EN_G2
#define EN_G2 1
#endif
#ifndef EN_G3
#define EN_G3 1
#endif
#ifndef EN_G4
#define EN_G4 1
#endif
#ifndef EN_ATT
#define EN_ATT 1
#endif
#ifndef EN_LRUA
#define EN_LRUA 1
#endif
#ifndef EN_LRUB
#define EN_LRUB 1
#endif
#ifndef REP_P0
#define REP_P0 1
#endif
#ifndef REP_P1
#define REP_P1 1
#endif
#ifndef REP_G1
#define REP_G1 1
#endif
#ifndef REP_G3
#define REP_G3 1
#endif
#ifndef REP_ATT
#define REP_ATT 1
#endif
#ifndef REP_LRUA
#define REP_LRUA 1
#endif
#ifndef REP_LRUB
#define REP_LRUB 1
#endif
#ifndef REP_G2
#define REP_G2 1
#endif
#ifndef REP_G4
#define REP_G4 1
#endif
#ifndef EXTRA_SYNCS
#define EXTRA_SYNCS 0
#endif
#ifndef STAG_G2
#define STAG_G2 0
#endif
#ifndef STAG_G4
#define STAG_G4 0
#endif
__device__ __forceinline__ void phase_stagger(int bx, unsigned ticks) {
    if (ticks == 0u) return;
    const unsigned long long t0 = __builtin_amdgcn_s_memrealtime(), dl = (unsigned long long)(((unsigned)bx >> 3) & 3u) * ticks;
    while (__builtin_amdgcn_s_memrealtime() - t0 < dl) __builtin_amdgcn_s_sleep(16);
}
__global__ void __launch_bounds__(512, 2) fwd_megakernel(Args a) {
    extern __shared__ __attribute__((aligned(16))) unsigned char lds_raw[];
    LAS unsigned char* lds = (LAS unsigned char*)lds_raw;
    cg::grid_group grid = cg::this_grid();
    volatile LAS unsigned* bst = (volatile LAS unsigned*)(lds + 151040);
    if (threadIdx.x < 2) bst[threadIdx.x] = 0u;
    __syncthreads();
    const XcdBarrier xbar = xcd_barrier_post((unsigned*)a.ws, bst);
#define GRID_SYNC() xcd_barrier(xbar)
    const int G = gridDim.x, bx = blockIdx.x, NGW = G * 8;
#define PHASE_IDS() const int tid = opaque_tid(), lane = tid & 63, wave = __builtin_amdgcn_readfirstlane(tid >> 6), gw = bx * 8 + wave; (void)lane; (void)gw
    unsigned char* ws = a.ws;
    bf16_t* Wt_in = (bf16_t*)(ws + WS_WIN); bf16_t* Wt_out = (bf16_t*)(ws + WS_WOUT); bf16_t* Wt_fi = (bf16_t*)(ws + WS_WFI); bf16_t* Wt_fo = (bf16_t*)(ws + WS_WFO);
    bf16_t* Wg = (bf16_t*)(ws + WS_WG); float* mod = (float*)(ws + WS_MOD); float* shw1 = (float*)(ws + WS_SHW1); float* shw2 = (float*)(ws + WS_SHW2);
    float* rsq1 = (float*)(ws + WS_RSQ1); float* rsq2 = (float*)(ws + WS_RSQ2); f32x2* agg = (f32x2*)(ws + WS_AGG); float* clamt = (float*)(ws + WS_CLAM); float* asq = (float*)(ws + WS_CLAM + 65536);
    bf16_t* hb = (bf16_t*)a.out;
    unsigned short* xh = (unsigned short*)(ws + WS_HB); bf16_t* zb = (bf16_t*)(ws + WS_Z); bf16_t* mix = (bf16_t*)(ws + WS_MIX); bf16_t* hid = (bf16_t*)(ws + WS_HID);

    for (int rep_ = 0; rep_ < REP_P0; ++rep_) {
        PHASE_IDS();
        LAS float* vl = (LAS float*)lds; LAS float* red = (LAS float*)(lds + 81920);
        if (bx < 384) {
            for (int i = tid; i < NB * 1024; i += 512) { const int b = i >> 10, k = i & 1023; const float v = b < 4 ? a.in[2][b * 1024 + k] : a.in[3][(b - 4) * 1024 + k];
                vl[k * NB + b] = v * fsigmoid(v); }
            __syncthreads();
            for (int it = bx; it < 384; it += G) { const int l = it / 96, chk = it % 96;
                gemv20_item(a.in[4] + (size_t)l * DM * NMODC, NMODC, chk * 64, vl, red, mod + (size_t)l * NB * NMODC, NMODC, chk * 64, a.in[5] + (size_t)l * NMODC); }
        }
        __syncthreads();
        LAS float* scr = (LAS float*)(lds + wave * 8448);
        constexpr int I_IN = 16 * 56, I_OUT = 16 * 32, I_FI = 16 * 176, I_FO = 44 * 32, I_L = I_IN + I_OUT + I_FI + I_FO;
        for (int it = gw; it < NLAYER * I_L; it += NGW) { const int l = it / I_L; int r = it % I_L;
            if (r < I_IN) { transpose_item<0>(a.in[7] + (size_t)l * DM * DIN, DM, DIN, Wt_in + (size_t)l * DIN * DM, scr, r, lane); continue; } r -= I_IN;
            if (r < I_OUT) { transpose_item<0>(a.in[18] + (size_t)l * DM * DM, DM, DM, Wt_out + (size_t)l * DM * DM, scr, r, lane); continue; } r -= I_OUT;
            if (r < I_FI) { transpose_item<1>(a.in[20] + (size_t)l * DM * NFI, DM, NFI, Wt_fi + (size_t)l * NFI * DM, scr, r, lane); continue; } r -= I_FI;
            transpose_item<0>(a.in[21] + (size_t)l * DFF * DM, DFF, DM, Wt_fo + (size_t)l * DM * DFF, scr, r, lane); }
        for (int i = bx * 512 + tid; i < NLAYER * 2 * 2 * 8 * 64 * 64; i += G * 512) { const int c = i & 63, m = (i >> 6) & 63, blk = (i >> 12) & 7, gate = (i >> 15) & 1, dir = (i >> 16) & 1, l = i >> 17;
            const float* src = gate ? a.in[13] : a.in[11]; const float v = src[((size_t)((l * 2 + dir) * 8 + blk) * 64 + c) * 64 + m];
            Wg[i] = (bf16_t)(cvt_pk_bf16(v, 0.f) & 0xffffu); }
        for (int i = bx * 512 + tid; i < NLAYER * 1024; i += G * 512) clamt[i] = -8.0f * log1pf(expf(-a.in[15][i])) * LOG2E;
    }
    grid.sync();
    for (int rep_ = 0; rep_ < REP_P1; ++rep_) {
        PHASE_IDS();
        {
            const int grp = bx & 7, l = grp >> 1, which = grp & 1, ldn = which ? NFI : DIN, nitems = ldn / 32;
            const float* src = mod + (size_t)l * NB * NMODC + (which ? 3072 : 0);
            constexpr int SHP = 2064;
            for (int i = tid; i < 32 * 128; i += 512) { const int b = i >> 7, k8 = (i & 127) * 8; u32x4 w = {0u, 0u, 0u, 0u};
                if (b < NB) { const f32x4 v0 = *(const f32x4*)(src + (size_t)b * NMODC + k8), v1 = *(const f32x4*)(src + (size_t)b * NMODC + k8 + 4);
                    w.x = cvt_pk_bf16(v0[0], v0[1]); w.y = cvt_pk_bf16(v0[2], v0[3]); w.z = cvt_pk_bf16(v1[0], v1[1]); w.w = cvt_pk_bf16(v1[2], v1[3]); }
                *(LAS u32x4*)(lds + b * SHP + k8 * 2) = w; }
            __syncthreads();
            const bf16_t* Wt = which ? Wt_fi + (size_t)l * NFI * DM : Wt_in + (size_t)l * DIN * DM; float* dst = which ? shw2 + (size_t)l * NB * NFI : shw1 + (size_t)l * NB * DIN;
            const int r32 = lane & 31, hi = lane >> 5;
            for (int it = (bx >> 3) * 8 + wave; it < nitems; it += 256) {
                f32x16 acc;
#pragma unroll
                for (int r = 0; r < 16; ++r) acc[r] = 0.f;
                const bf16_t* wrow = Wt + (size_t)(it * 32 + r32) * DM + hi * 8;
#pragma unroll 16
                for (int ks = 0; ks < 64; ++ks) { const bf16x8 af = *(LAS const bf16x8*)(lds + r32 * SHP + (16 * ks + 8 * hi) * 2); const bf16x8 bfv = *(const bf16x8*)(wrow + 16 * ks);
                    acc = __builtin_amdgcn_mfma_f32_32x32x16_bf16(af, bfv, acc, 0, 0, 0); }
#pragma unroll
                for (int r = 0; r < 16; ++r) { const int b = crow(r, hi); if (b < NB) dst[(size_t)b * ldn + it * 32 + r32] = acc[r]; }
            }
            __syncthreads();
        }
        for (int row0_ = gw; row0_ < MTOK; row0_ += 2 * NGW) {
            f32x4 v[2][4]; float ssv[2];
#pragma unroll
            for (int rr = 0; rr < 2; ++rr) { const int row = row0_ + rr * NGW; const float* xr = row < 16384 ? a.in[0] + (size_t)row * DM : a.in[1] + (size_t)(row - 16384) * DM;
#pragma unroll
                for (int j = 0; j < 4; ++j) v[rr][j] = ((const f32x4*)xr)[64 * j + lane]; }
#pragma unroll
            for (int rr = 0; rr < 2; ++rr) { float ss = 0.f;
#pragma unroll
                for (int j = 0; j < 4; ++j) ss += (v[rr][j][0] * v[rr][j][0] + v[rr][j][1] * v[rr][j][1]) + (v[rr][j][2] * v[rr][j][2] + v[rr][j][3] * v[rr][j][3]);
                ssv[rr] = wave_sum(ss); }
#pragma unroll
            for (int rr = 0; rr < 2; ++rr) { const int row = row0_ + rr * NGW; const int b = row_batch(row);
#pragma unroll
                for (int j = 0; j < 4; ++j) { const int col = (64 * j + lane) * 4; { typedef _Float16 f16x4 __attribute__((ext_vector_type(4))); *(u32x2*)(xh + (size_t)row * DM + col) = __builtin_bit_cast(u32x2, __builtin_convertvector(v[rr][j], f16x4)); }
                    const f32x4 g4 = *(const f32x4*)(a.in[6] + col), s4 = *(const f32x4*)(mod + (size_t)b * NMODC + 1024 + col); const f32x4 hv = v[rr][j] * g4 * (s4 + 1.0f);
                    u32x2 w2; w2.x = cvt_pk_bf16(hv[0], hv[1]); w2.y = cvt_pk_bf16(hv[2], hv[3]); *(u32x2*)(hb + (size_t)row * DM + col) = w2; }
                if (lane < 16) rsq1[(size_t)lane * MTOK + row] = lane == 0 ? ssv[rr] : 0.f; }
        }
    }
    GRID_SYNC();
#pragma unroll 1
    for (int l = 0; l < NLAYER; ++l) {
        const float* modl = mod + (size_t)l * NB * NMODC;
        for (int rep_ = 0; rep_ < REP_G1; ++rep_) {
            pg8::Gemm g{hb, Wt_in + (size_t)l * DIN * DM, MTOK, DIN, DM}; pg8::StaticOrder S; S.init(MTOK, DIN, G, bx);
            pg8::EpiZ E{zb, DIN, rsq1, shw1 + (size_t)l * NB * DIN, lds};
            pg8::gemm_phase<pg8::EpiZ, pg8::StaticOrder, true, true>(lds, g, S, E);
        }
        GRID_SYNC();
        if (EN_ATT || EN_LRUA) {
            LruP P{a.in[9] + (size_t)l * 4 * 512, a.in[10] + (size_t)l * 512, a.in[12] + (size_t)l * 1024, a.in[14] + (size_t)l * 1024, clamt + (size_t)l * 1024, a.in[17] + (size_t)l * 512, Wg + (size_t)l * 2 * 2 * 8 * 64 * 64};
            {
                const int wv = __builtin_amdgcn_readfirstlane(opaque_tid() >> 6);
                if (wv < 4) { for (int u = bx; u < 768; u += G) attn_wave(u, wv, zb, mix, asq, a.in[8] + l * 8, lds); }
                else { LAS unsigned char* xc = lds + 4 * AW_BYTES + (wv - 4) * 9648;
                    for (int u = bx; u < 768; u += G) { lru_unit<false>(u, 2 * (wv - 4), xc, zb, mix, P, agg, lds); lru_unit<false>(u, 2 * (wv - 4) + 1, xc, zb, mix, P, agg, lds); } }
            }
        }
        GRID_SYNC();
        for (int rep_ = 0; rep_ < REP_LRUB; ++rep_) {
            LruP P{a.in[9] + (size_t)l * 4 * 512, a.in[10] + (size_t)l * 512, a.in[12] + (size_t)l * 1024, a.in[14] + (size_t)l * 1024, clamt + (size_t)l * 1024, a.in[17] + (size_t)l * 512, Wg + (size_t)l * 2 * 2 * 8 * 64 * 64};
            { const int wv = __builtin_amdgcn_readfirstlane(opaque_tid() >> 6);
              for (int u = bx; u < 768; u += G) { lru_unit<true>(u, wv, lds + wv * 9648, zb, mix, P, agg, lds);
                  attn_norm_rows(mix + (size_t)u * 64 * DM, asq + (size_t)u * 64 * 2, a.in[16] + (size_t)l * 512); } }
        }
        GRID_SYNC();
        for (int rep_ = 0; rep_ < REP_G2; ++rep_) {
            pg8::Gemm g{mix, Wt_out + (size_t)l * DM * DM, MTOK, DM, DM}; pg8::StaticOrder S; S.init(MTOK, DM, G, bx);
            pg8::EpiRes E{xh, modl + 2048, a.in[19] + (size_t)l * DM, modl + 4096, hb, rsq2, rep_ == REP_G2 - 1 ? 1.0f : 0.0f};
            phase_stagger(bx, STAG_G2);
            pg8::gemm_phase<pg8::EpiRes, pg8::StaticOrder, true, true>(lds, g, S, E);
        }
        GRID_SYNC();
        for (int rep_ = 0; rep_ < REP_G3; ++rep_) {
            pg8::Gemm g{hb, Wt_fi + (size_t)l * NFI * DM, MTOK, NFI, DM}; pg8::StaticOrder S; S.init(MTOK, NFI, G, bx);
            pg8::EpiSwiGLU E{hid, rsq2, shw2 + (size_t)l * NB * NFI, lds};
            pg8::gemm_phase<pg8::EpiSwiGLU, pg8::StaticOrder, true, true>(lds, g, S, E);
        }
        GRID_SYNC();
        for (int rep_ = 0; rep_ < REP_G4; ++rep_) {
            const bool last = (l == NLAYER - 1);
            pg8::Gemm g{hid, Wt_fo + (size_t)l * DM * DFF, MTOK, DM, DFF}; pg8::StaticOrder S; S.init(MTOK, DM, G, bx);
            pg8::EpiRes E{xh, modl + 5120, last ? a.in[6] : a.in[6] + (size_t)(l + 1) * DM, last ? modl + 1024 : modl + (size_t)NB * NMODC + 1024, last ? (bf16_t*)nullptr : hb, rsq1, rep_ == REP_G4 - 1 ? 1.0f : 0.0f};
            phase_stagger(bx, STAG_G4);
            pg8::gemm_phase<pg8::EpiRes, pg8::StaticOrder, true, true>(lds, g, S, E);
        }
        GRID_SYNC();
    }
    for (int e_ = 0; e_ < EXTRA_SYNCS; ++e_) GRID_SYNC();
    PHASE_IDS();
    for (int row0_ = gw; row0_ < MTOK; row0_ += 2 * NGW) {
        typedef _Float16 f16x4 __attribute__((ext_vector_type(4)));
        u32x2 xv[2][4]; float sp[2];
#pragma unroll
        for (int rr = 0; rr < 2; ++rr) { const int row = row0_ + rr * NGW; sp[rr] = lane < 16 ? rsq1[(size_t)lane * MTOK + row] : 0.f;
#pragma unroll
            for (int j = 0; j < 4; ++j) xv[rr][j] = ((const u32x2*)(xh + (size_t)row * DM))[64 * j + lane]; }
#pragma unroll
        for (int rr = 0; rr < 2; ++rr) { const int row = row0_ + rr * NGW; const float rs = rsqrtf(wave_sum(sp[rr]) * (1.0f / DM) + EPS); f32x4* orow = (f32x4*)(a.out + (size_t)row * DM);
#pragma unroll
            for (int j = 0; j < 4; ++j) { const f32x4 v = __builtin_convertvector(__builtin_bit_cast(f16x4, xv[rr][j]), f32x4), g4 = ((const f32x4*)a.in[22])[64 * j + lane]; orow[64 * j + lane] = v * rs * g4; } }
    }
}

extern "C" void kernel_launch(void* const* d_in, const int* in_sizes, int n_in, void* d_out, int out_size, void* d_ws, size_t ws_size, hipStream_t stream) {
    static int grid = 0;
    if (grid == 0) {
        int dev = 0, cus = 0, per_cu = 0;
        (void)hipGetDevice(&dev);
        (void)hipDeviceGetAttribute(&cus, hipDeviceAttributeMultiprocessorCount, dev);
        (void)hipFuncSetAttribute((const void*)fwd_megakernel, hipFuncAttributeMaxDynamicSharedMemorySize, LDS_BYTES);
        (void)hipOccupancyMaxActiveBlocksPerMultiprocessor(&per_cu, (const void*)fwd_megakernel, 512, LDS_BYTES);
        (void)hipGetLastError();
        grid = cus > 0 ? cus : 256;
        if (n_in != 23 || ws_size < WS_END) { fprintf(stderr, "kernel_launch: unexpected n_in %d / ws %zu\n", n_in, ws_size); }
    }
    (void)hipMemsetAsync(d_ws, 0, 16384, stream);
    Args a{};
    for (int i = 0; i < 23; ++i) a.in[i] = (const float*)d_in[i];
    a.out = (float*)d_out; a.ws = (unsigned char*)d_ws;
    void* args[] = {&a};
    hipError_t e = hipLaunchCooperativeKernel((const void*)fwd_megakernel, dim3(grid), dim3(512), args, LDS_BYTES, stream);
    if (e != hipSuccess) fprintf(stderr, "cooperative launch failed: %s (grid %d)\n", hipGetErrorString(e), grid);
}
```
